# Optimizing an MI355X kernel written in HIP

```python
import math
import jax, jax.numpy as jnp
from jax import lax
import numpy as np

D_MODEL = 2048
BATCH = 4
SEQ = 4096
DEPTH = 4

M_HEADS = 8
M_QK_DIM = 128
M_V_DIM = 256
M_CHUNK = 64
CONV_K = 4
M_QK = M_HEADS * M_QK_DIM
M_V = M_HEADS * M_V_DIM
D_HEADS = 8
D_QK_DIM = 128
D_V_DIM = 2 * D_QK_DIM
D_Q = D_HEADS * 2 * D_QK_DIM
D_V = D_HEADS * D_V_DIM
Q_BLOCK = 128
D_FF = -(-8 * D_MODEL // 768) * 256
EPS = 1e-6
IN_SIZES = (M_QK, M_QK, M_V, M_V, M_HEADS, M_HEADS, D_Q, D_Q, D_V, D_MODEL, D_MODEL)
N_IN = sum(IN_SIZES)

kernel_name = "hybrid_mlstm_diffattn_gated_block"


def rmsnorm(x, w):
    xf = x.astype(jnp.float32)
    y = xf * lax.rsqrt(jnp.mean(xf * xf, axis=-1, keepdims=True) + EPS)
    return (y * w.astype(jnp.float32)).astype(x.dtype)


def head_rmsnorm(x, w):
    B, S, H, d = x.shape
    xf = x.astype(jnp.float32)
    y = xf * lax.rsqrt(jnp.mean(xf * xf, axis=-1, keepdims=True) + EPS)
    return y.reshape(B, S, H * d) * w.astype(jnp.float32)


def split_in(proj):
    outs, off = [], 0
    for n in IN_SIZES:
        outs.append(proj[..., off:off + n])
        off += n
    return outs


def causal_dwconv(u, w, b):
    C = u.shape[-1]
    y = lax.conv_general_dilated(u, w[:, None, :].astype(u.dtype), window_strides=(1,),
                                 padding=[(CONV_K - 1, 0)],
                                 dimension_numbers=('NWC', 'WIO', 'NWC'),
                                 feature_group_count=C)
    return y + b.astype(u.dtype)


def mlstm_chunkwise(q, k, v, ig, lf):
    B, S, H, dk = q.shape
    dv = v.shape[-1]
    nc = S // M_CHUNK

    def chunks(t):
        t = t.reshape((B, nc, M_CHUNK) + t.shape[2:])
        return t.transpose((1, 0, 3, 2) + tuple(range(4, t.ndim)))

    tril = jnp.tril(jnp.ones((M_CHUNK, M_CHUNK), dtype=bool))

    def step(carry, xs):
        C, n, m = carry
        qc, kc, vc, igc, lfc = xs
        b = jnp.cumsum(lfc, axis=-1)
        log_d = jnp.where(tril, b[..., :, None] - b[..., None, :] + igc[..., None, :], -jnp.inf)
        log_inter = b + m[..., None]
        m_row = jnp.maximum(log_inter, jnp.max(log_d, axis=-1))
        dmat = jnp.exp(log_d - m_row[..., None])
        inter = jnp.exp(log_inter - m_row)
        s = jnp.einsum('bhld,bhsd->bhls', qc, kc) * dmat
        num = jnp.einsum('bhls,bhsv->bhlv', s, vc) + inter[..., None] * jnp.einsum('bhvd,bhld->bhlv', C, qc)
        den = jnp.sum(s, axis=-1) + inter * jnp.einsum('bhd,bhld->bhl', n, qc)
        h = num / jnp.maximum(jnp.abs(den), jnp.exp(-m_row))[..., None]
        bL = b[..., -1]
        log_w = bL[..., None] - b + igc
        m_new = jnp.maximum(bL + m, jnp.max(log_w, axis=-1))
        w = jnp.exp(log_w - m_new[..., None])
        decay = jnp.exp(bL + m - m_new)
        C_new = decay[..., None, None] * C + jnp.einsum('bhl,bhlv,bhld->bhvd', w, vc, kc)
        n_new = decay[..., None] * n + jnp.einsum('bhl,bhld->bhd', w, kc)
        return (C_new, n_new, m_new), h

    init = (jnp.zeros((B, H, dv, dk), jnp.float32), jnp.zeros((B, H, dk), jnp.float32),
            jnp.zeros((B, H), jnp.float32))
    _, hs = lax.scan(step, init, (chunks(q), chunks(k), chunks(v), chunks(ig), chunks(lf)))
    return hs.transpose(1, 0, 3, 2, 4).reshape(B, S, H, dv)


def diff_attention(q, k, v, lam):
    B, S, H, _, d = q.shape
    dv = v.shape[-1]
    nb = S // Q_BLOCK
    kt = k.transpose(0, 2, 3, 1, 4)
    vt = v.transpose(0, 2, 1, 3)
    qb = (q * (d ** -0.5)).reshape(B, nb, Q_BLOCK, H, 2, d).transpose(1, 0, 3, 4, 2, 5)
    kpos = jnp.arange(S)

    def block(args):
        qblk, start = args
        s = jnp.einsum('bhcqd,bhckd->bhcqk', qblk, kt).astype(jnp.float32)
        qpos = start + jnp.arange(Q_BLOCK)
        mask = kpos[None, :] <= qpos[:, None]
        p = jax.nn.softmax(jnp.where(mask, s, -jnp.inf), axis=-1)
        a = p[:, :, 0] - lam * p[:, :, 1]
        return jnp.einsum('bhqk,bhkv->bhqv', a.astype(v.dtype), vt)

    out = lax.map(block, (qb, jnp.arange(nb, dtype=jnp.int32) * Q_BLOCK))
    return out.transpose(1, 0, 3, 2, 4).reshape(B, S, H, dv)


def hybrid_mixer(h, w_in, conv_w, conv_b, b_ig, b_fg, m_norm_w, lq1, lk1, lq2, lk2,
                 d_norm_w, w_bm, w_bd, w_out, lam_init):
    B, S, _ = h.shape
    proj = h @ w_in
    mq, mk, mv, mo, mi, mf, dq, dk, dv, gm, gd = split_in(proj)
    qk = jax.nn.silu(causal_dwconv(jnp.concatenate([mq, mk], axis=-1), conv_w, conv_b))
    q = qk[..., :M_QK].reshape(B, S, M_HEADS, M_QK_DIM).astype(jnp.float32)
    k = qk[..., M_QK:].reshape(B, S, M_HEADS, M_QK_DIM).astype(jnp.float32) * (M_QK_DIM ** -0.5)
    v = mv.reshape(B, S, M_HEADS, M_V_DIM).astype(jnp.float32)
    ig = (mi + b_ig).astype(jnp.float32)
    lf = jax.nn.log_sigmoid((mf + b_fg).astype(jnp.float32))
    hm = mlstm_chunkwise(q, k, v, ig, lf)
    hm = jax.nn.sigmoid(mo) * head_rmsnorm(hm, m_norm_w).astype(h.dtype)
    lam = (jnp.exp(jnp.sum(lq1.astype(jnp.float32) * lk1.astype(jnp.float32)))
           - jnp.exp(jnp.sum(lq2.astype(jnp.float32) * lk2.astype(jnp.float32))) + lam_init)
    hd = diff_attention(dq.reshape(B, S, D_HEADS, 2, D_QK_DIM), dk.reshape(B, S, D_HEADS, 2, D_QK_DIM),
                        dv.reshape(B, S, D_HEADS, D_V_DIM), lam)
    hd = (head_rmsnorm(hd, d_norm_w) * (1.0 - lam_init)).astype(h.dtype)
    y = jax.nn.sigmoid(gm) * (hm @ w_bm) + jax.nn.sigmoid(gd) * (hd @ w_bd)
    return y @ w_out


def swiglu(h, w_gate, w_up, w_down):
    return (jax.nn.silu(h @ w_gate) * (h @ w_up)) @ w_down


def setup_inputs(seed: int = 0) -> dict:
    key = jax.random.key(seed)
    ks = jax.random.split(key, 24)
    nrm = lambda k, shape, s: jax.random.normal(k, shape, jnp.float32) * s
    L = DEPTH
    f_bias = jnp.linspace(3.0, 6.0, M_HEADS, dtype=jnp.float32)[None, :] + nrm(ks[6], (L, M_HEADS), 0.1)
    return {
        "x": nrm(ks[0], (BATCH, SEQ, D_MODEL), 1.0),
        "attn_norm_w": 1.0 + nrm(ks[1], (L, D_MODEL), 0.02),
        "w_in": nrm(ks[2], (L, D_MODEL, N_IN), D_MODEL ** -0.5),
        "conv_w": nrm(ks[3], (L, CONV_K, 2 * M_QK), CONV_K ** -0.5),
        "conv_b": nrm(ks[4], (L, 2 * M_QK), 0.01),
        "b_igate": nrm(ks[5], (L, M_HEADS), 0.1),
        "b_fgate": f_bias,
        "mlstm_norm_w": 1.0 + nrm(ks[7], (L, M_V), 0.02),
        "lambda_q1": nrm(ks[8], (L, D_QK_DIM), 0.1),
        "lambda_k1": nrm(ks[9], (L, D_QK_DIM), 0.1),
        "lambda_q2": nrm(ks[10], (L, D_QK_DIM), 0.1),
        "lambda_k2": nrm(ks[11], (L, D_QK_DIM), 0.1),
        "diff_norm_w": 1.0 + nrm(ks[12], (L, D_V), 0.02),
        "w_branch_m": nrm(ks[13], (L, M_V, D_MODEL), M_V ** -0.5),
        "w_branch_d": nrm(ks[14], (L, D_V, D_MODEL), D_V ** -0.5),
        "w_out": nrm(ks[15], (L, D_MODEL, D_MODEL), D_MODEL ** -0.5),
        "ffn_norm_w": 1.0 + nrm(ks[16], (L, D_MODEL), 0.02),
        "w_ffn_gate": nrm(ks[17], (L, D_MODEL, D_FF), D_MODEL ** -0.5),
        "w_ffn_up": nrm(ks[18], (L, D_MODEL, D_FF), D_MODEL ** -0.5),
        "w_ffn_down": nrm(ks[19], (L, D_FF, D_MODEL), D_FF ** -0.5),
        "final_norm_w": 1.0 + nrm(ks[20], (D_MODEL,), 0.02),
    }


def reference(x, attn_norm_w, w_in, conv_w, conv_b, b_igate, b_fgate, mlstm_norm_w,
              lambda_q1, lambda_k1, lambda_q2, lambda_k2, diff_norm_w, w_branch_m, w_branch_d,
              w_out, ffn_norm_w, w_ffn_gate, w_ffn_up, w_ffn_down, final_norm_w):
    for l in range(DEPTH):
        lam_init = 0.8 - 0.6 * math.exp(-0.3 * l)
        h = rmsnorm(x, attn_norm_w[l])
        x = x + hybrid_mixer(h, w_in[l], conv_w[l], conv_b[l], b_igate[l], b_fgate[l], mlstm_norm_w[l],
                             lambda_q1[l], lambda_k1[l], lambda_q2[l], lambda_k2[l], diff_norm_w[l],
                             w_branch_m[l], w_branch_d[l], w_out[l], lam_init)
        h = rmsnorm(x, ffn_norm_w[l])
        x = x + swiglu(h, w_ffn_gate[l], w_ffn_up[l], w_ffn_down[l])
    return rmsnorm(x, final_norm_w)
```

```cpp
#include <hip/hip_runtime.h>
#include <hip/hip_bf16.h>
#include <cstdio>
#include <cstdint>
__device__ __forceinline__ int tidx() { int t = (int)threadIdx.x; asm volatile("" : "+v"(t)); return t; }
__device__ __forceinline__ int sopq(int v) { asm volatile("" : "+s"(v)); return v; }
namespace pg8 {
#define PG8_LAS __attribute__((address_space(3)))
typedef unsigned short bf16_t;
typedef short bf16x8 __attribute__((ext_vector_type(8)));
typedef float f32x4 __attribute__((ext_vector_type(4)));
typedef unsigned u32x4 __attribute__((ext_vector_type(4)));
constexpr int BM = 256, BK = 64, HALF = 128, HTB = HALF * BK * 2  , STAGE_BYTES = 8 * HTB, NXCD = 8, WGM = 8;

__host__ __device__ __forceinline__ int lds_byte(int r, int c) { const int st = (r >> 4) * 2 + (c >> 5), rr = r & 15, cc = c & 31, ob = rr * 64 + cc * 2; return st * 1024 + (ob ^ (((ob >> 9) & 1) << 5)); }
__host__ __device__ __forceinline__ void stage_rc(int b, int& R, int& C) { const int st = b / 1024, sb = b % 1024, swz = sb ^ (((sb >> 9) & 1) << 5); R = (st >> 1) * 16 + swz / 64; C = (st & 1) * 32 + (swz % 64) / 2; }
__host__ __device__ __forceinline__ int perm32(int rho) { const int n = rho >> 4, i = rho & 15; return 8 * (i >> 2) + 4 * n + (i & 3); }

struct Unit { int pm, pn, kh; };
struct Gemm { const bf16_t* A; const bf16_t* Bt; int M, N, K, ld; };

struct StaticOrder {
    int nM, nN, nwg, G, c;
    __host__ __device__ void init(int M, int N, int G_, int c_) { nM = M / BM; nN = N / BM; nwg = nM * nN; G = G_; c = c_; }
    __host__ __device__ bool next(int i, Unit& u) const {
        const long L = (long)i * G + c; if (L >= nwg) return false;
        int wgid = (int)L; { const int q = nwg / NXCD, r = nwg % NXCD, xcd = wgid % NXCD, off = wgid / NXCD; wgid = (xcd < r ? xcd * (q + 1) : r * (q + 1) + (xcd - r) * q) + off; }
        const int nig = WGM * nN, gid = wgid / nig, fm = gid * WGM, gsz = (nM - fm) < WGM ? (nM - fm) : WGM;
        u.pm = fm + ((wgid % nig) % gsz); u.pn = (wgid % nig) / gsz; u.kh = 0; return true;
    }
    __device__ __forceinline__ void a_ready(const Unit&) const {}
    __device__ __forceinline__ void done(const Unit&) const {}
};
struct HalfKOrder : StaticOrder {
    __host__ __device__ bool next(int i, Unit& u) const { const bool ok = StaticOrder::next(i >> 1, u); u.kh = i & 1; return ok; }
};

__device__ __forceinline__ unsigned cvt_pk_bf16(float lo, float hi) { unsigned r; asm volatile("v_cvt_pk_bf16_f32 %0, %1, %2" : "=v"(r) : "v"(lo), "v"(hi)); return r; }
typedef float f32x2 __attribute__((ext_vector_type(2)));
typedef unsigned u32x2 __attribute__((ext_vector_type(2)));
__device__ __forceinline__ float bf_lo(unsigned w) { return __uint_as_float(w << 16); }
__device__ __forceinline__ float bf_hi(unsigned w) { return __uint_as_float(w & 0xffff0000u); }
__device__ __forceinline__ float sigmoidf_(float x) { return 1.0f / (1.0f + __expf(-x)); }

struct EpiStoreBf16 {
    static constexpr bool PERM = true, AFTER_DRAIN = false, MID = false;
    bf16_t* O; int ldc;
    __device__ __forceinline__ void operator()(f32x4 (&acc)[2][2][4][2], const Unit& u, int wr, int wc, int fr, int fq) const {
        const int row0 = u.pm * BM + wr * 64 + fr, col0 = u.pn * BM + wc * 32 + 8 * fq;
#pragma unroll
        for (int ai = 0; ai < 2; ++ai)
#pragma unroll
            for (int m = 0; m < 4; ++m) { bf16_t* rowp = O + (size_t)(row0 + ai * HALF + m * 16) * ldc + col0;
#pragma unroll
                for (int bj = 0; bj < 2; ++bj) { const f32x4 v0 = acc[ai][bj][m][0], v1 = acc[ai][bj][m][1];
                    u32x4 w; w.x = cvt_pk_bf16(v0[0], v0[1]); w.y = cvt_pk_bf16(v0[2], v0[3]); w.z = cvt_pk_bf16(v1[0], v1[1]); w.w = cvt_pk_bf16(v1[2], v1[3]);
                    *(u32x4*)(rowp + bj * HALF) = w; } }
    }
};
struct EpiResid {
    static constexpr bool PERM = false, AFTER_DRAIN = false, MID = false;
    const float* xin; float* xout; int ldc;
    __device__ __forceinline__ void operator()(f32x4 (&acc)[2][2][4][2], const Unit& u, int wr, int wc, int fr, int fq) const {
        const int row0 = u.pm * BM + wr * 64 + fr, col0 = u.pn * BM + wc * 32 + 4 * fq;
#pragma unroll
        for (int ai = 0; ai < 2; ++ai)
#pragma unroll
            for (int m = 0; m < 4; ++m) { const size_t off = (size_t)(row0 + ai * HALF + m * 16) * ldc + col0;
#pragma unroll
                for (int bj = 0; bj < 2; ++bj)
#pragma unroll
                    for (int n = 0; n < 2; ++n) { const size_t o2 = off + bj * HALF + n * 16; const f32x4 xv = *(const f32x4*)(xin + o2); *(f32x4*)(xout + o2) = xv + acc[ai][bj][m][n]; } }
    }
};
struct EpiSwiglu {
    static constexpr bool PERM = true, AFTER_DRAIN = false, MID = false;
    bf16_t* O; int ldc;
    __device__ __forceinline__ void operator()(f32x4 (&acc)[2][2][4][2], const Unit& u, int wr, int wc, int fr, int fq) const {
        const int row0 = u.pm * BM + wr * 64 + fr, col0 = u.pn * HALF + wc * 32 + 8 * fq;
#pragma unroll
        for (int ai = 0; ai < 2; ++ai)
#pragma unroll
            for (int m = 0; m < 4; ++m) { bf16_t* rowp = O + (size_t)(row0 + ai * HALF + m * 16) * ldc + col0;
                float r[8];
#pragma unroll
                for (int n = 0; n < 2; ++n)
#pragma unroll
                    for (int i = 0; i < 4; ++i) { const float g = acc[ai][0][m][n][i], up = acc[ai][1][m][n][i]; r[n * 4 + i] = g * sigmoidf_(g) * up; }
                u32x4 w; w.x = cvt_pk_bf16(r[0], r[1]); w.y = cvt_pk_bf16(r[2], r[3]); w.z = cvt_pk_bf16(r[4], r[5]); w.w = cvt_pk_bf16(r[6], r[7]);
                *(u32x4*)rowp = w; }
    }
};
struct EpiGated {
    static constexpr bool PERM = true, AFTER_DRAIN = false, MID = true;
    const bf16_t* P; int ldp, cgm, cgd; bf16_t* O; int ldc;
    __device__ __forceinline__ static float cl(float x) { return fminf(fmaxf(x, -30.f), 30.f); }
    __device__ __forceinline__ void operator()(f32x4 (&acc)[2][2][4][2], const Unit& u, int wr, int wc, int fr, int fq) const { if (u.kh == 0) mid(acc, u, wr, wc, fr, fq); else fin(acc, u, wr, wc, fr, fq); }
    __device__ __forceinline__ void mid(f32x4 (&acc)[2][2][4][2], const Unit& u, int wr, int wc, int fr, int fq) const {
        const int row0 = u.pm * BM + wr * 64 + fr, col0 = u.pn * BM + wc * 32 + 8 * fq;
#pragma unroll
        for (int ai = 0; ai < 2; ++ai)
#pragma unroll
            for (int m = 0; m < 4; ++m) { const bf16_t* rowp = P + (size_t)(row0 + ai * HALF + m * 16) * ldp + col0;
#pragma unroll
                for (int bj = 0; bj < 2; ++bj) { const u32x4 a = *(const u32x4*)(rowp + cgm + bj * HALF), b = *(const u32x4*)(rowp + cgd + bj * HALF);
                    const unsigned aw[4] = {a.x, a.y, a.z, a.w}, bw[4] = {b.x, b.y, b.z, b.w};
#pragma unroll
                    for (int k = 0; k < 4; ++k) { const float gm0 = cl(bf_lo(aw[k])), gm1 = cl(bf_hi(aw[k])), gd0 = cl(bf_lo(bw[k])), gd1 = cl(bf_hi(bw[k]));
                        const float r0 = (1.0f + __expf(-gd0)) / (1.0f + __expf(-gm0)), r1 = (1.0f + __expf(-gd1)) / (1.0f + __expf(-gm1));
                        acc[ai][bj][m][k >> 1][(k & 1) * 2] *= r0; acc[ai][bj][m][k >> 1][(k & 1) * 2 + 1] *= r1; } }
                asm volatile("" ::: "memory"); }
    }
    __device__ __forceinline__ void fin(f32x4 (&acc)[2][2][4][2], const Unit& u, int wr, int wc, int fr, int fq) const {
        const int row0 = u.pm * BM + wr * 64 + fr, col0 = u.pn * BM + wc * 32 + 8 * fq;
#pragma unroll
        for (int ai = 0; ai < 2; ++ai)
#pragma unroll
            for (int m = 0; m < 4; ++m) { const size_t r = (size_t)(row0 + ai * HALF + m * 16); const bf16_t* gp = P + r * ldp + cgd + col0; bf16_t* rowp = O + r * ldc + col0;
#pragma unroll
                for (int bj = 0; bj < 2; ++bj) { const u32x4 b = *(const u32x4*)(gp + bj * HALF); const unsigned bw[4] = {b.x, b.y, b.z, b.w}; float o[8];
#pragma unroll
                    for (int k = 0; k < 4; ++k) { const float s0 = sigmoidf_(cl(bf_lo(bw[k]))), s1 = sigmoidf_(cl(bf_hi(bw[k])));
                        o[2 * k] = acc[ai][bj][m][k >> 1][(k & 1) * 2] * s0; o[2 * k + 1] = acc[ai][bj][m][k >> 1][(k & 1) * 2 + 1] * s1; }
                    u32x4 w; w.x = cvt_pk_bf16(o[0], o[1]); w.y = cvt_pk_bf16(o[2], o[3]); w.z = cvt_pk_bf16(o[4], o[5]); w.w = cvt_pk_bf16(o[6], o[7]);
                    *(u32x4*)(rowp + bj * HALF) = w; }
                asm volatile("" ::: "memory"); }
    }
};

template <class Epi, class Sched, bool ALIGN_EPI = false, bool SP2 = false>
__device__ __forceinline__ void gemm_phase(PG8_LAS unsigned char* lds, const Gemm g, const Sched& S, const Epi& E) {
    const int tid = tidx(), wid = __builtin_amdgcn_readfirstlane(tid >> 6), lane = tid & 63, wr = wid >> 2, wc = wid & 3, fr = lane & 15, fq = lane >> 4;
    const int K = g.K, nt = K / BK, LD = g.ld;
    unsigned voffA[2], voffB[2];
#pragma unroll
    for (int i = 0; i < 2; ++i) { int R, C; stage_rc(tid * 16 + i * 8192, R, C); const int Rb = Epi::PERM ? ((R & ~31) + perm32(R & 31)) : R;
        voffA[i] = (unsigned)(R * LD + C) * 2u; voffB[i] = (unsigned)(Rb * LD + C) * 2u; }
    const size_t kstep = (size_t)(BK * 2);
    const size_t hstep = (size_t)HALF * LD * 2;
    const size_t tstep = 2 * hstep;
    const unsigned ldsw = (unsigned)wid * 1024u;
    const int aoff = lds_byte(wr * 64 + fr, fq * 8), boff = lds_byte(wc * 32 + fr, fq * 8);
#define PG8_SA(b, h) (((b) * 2 + (h)) * HTB)
#define PG8_SB(b, h) ((4 + (b) * 2 + (h)) * HTB)
#define PG8_STAGE(bufoff, gbase, voff) do { _Pragma("unroll") for (int _i = 0; _i < 2; ++_i) \
        __builtin_amdgcn_global_load_lds((const unsigned*)((const char*)(gbase) + (voff)[_i]), (PG8_LAS unsigned*)(lds + (bufoff) + ldsw + _i * 8192), 16, 0, 0); } while (0)
#define PG8_LDA(dst, b, h) do { _Pragma("unroll") for (int m = 0; m < 4; ++m) _Pragma("unroll") for (int k = 0; k < 2; ++k) dst[m][k] = *(const PG8_LAS bf16x8*)(lds + PG8_SA(b, h) + aoff + m * 2048 + k * 1024); } while (0)
#define PG8_LDB(dst, b, h) do { _Pragma("unroll") for (int n = 0; n < 2; ++n) _Pragma("unroll") for (int k = 0; k < 2; ++k) dst[n][k] = *(const PG8_LAS bf16x8*)(lds + PG8_SB(b, h) + boff + n * 2048 + k * 1024); } while (0)
#define PG8_MMA(ai, bj, At, Bt) do { __builtin_amdgcn_s_setprio(1); _Pragma("unroll") for (int m = 0; m < 4; ++m) _Pragma("unroll") for (int n = 0; n < 2; ++n) _Pragma("unroll") for (int k = 0; k < 2; ++k) \
        acc[ai][bj][m][n] = __builtin_amdgcn_mfma_f32_16x16x32_bf16(Bt[n][k], At[m][k], acc[ai][bj][m][n], 0, 0, 0); __builtin_amdgcn_s_setprio(0); } while (0)
#define PG8_WAIT_V(n) asm volatile("s_waitcnt vmcnt(" #n ")" ::: "memory")
#define PG8_WAIT_L(n) asm volatile("s_waitcnt lgkmcnt(" #n ")" ::: "memory")
#define PG8_BAR __builtin_amdgcn_s_barrier()
#define PG8_SCHED __builtin_amdgcn_sched_barrier(0)
    Unit cur, nxt; int ui = 0;
    if (!S.next(0, cur)) return;
    f32x4 acc[2][2][4][2];
#pragma unroll
    for (int a = 0; a < 2; ++a)
#pragma unroll
        for (int b = 0; b < 2; ++b)
#pragma unroll
            for (int m = 0; m < 4; ++m)
#pragma unroll
                for (int n = 0; n < 2; ++n) acc[a][b][m][n] = (f32x4){0.f, 0.f, 0.f, 0.f};
    bf16x8 At[4][2], B0[2][2], B1[2][2];
    const size_t kslice = (size_t)K * 2;
    const char* cA = (const char*)g.A + (size_t)cur.pm * tstep + (size_t)cur.kh * kslice; const char* cB = (const char*)g.Bt + (size_t)cur.pn * tstep + (size_t)cur.kh * kslice;
    S.a_ready(cur);
    if constexpr (SP2) {
        PG8_STAGE(PG8_SB(0, 0), cB, voffB); PG8_STAGE(PG8_SB(0, 1), cB + hstep, voffB); PG8_STAGE(PG8_SA(0, 0), cA, voffA); PG8_STAGE(PG8_SA(0, 1), cA + hstep, voffA);
        if (wr == 1) PG8_BAR;
        PG8_WAIT_V(2); PG8_BAR;
        PG8_STAGE(PG8_SB(1, 0), cB + kstep, voffB); PG8_STAGE(PG8_SA(1, 0), cA + kstep, voffA); PG8_STAGE(PG8_SB(1, 1), cB + hstep + kstep, voffB);
        PG8_WAIT_V(6); PG8_BAR;
    } else {
        PG8_STAGE(PG8_SB(0, 0), cB, voffB); PG8_STAGE(PG8_SA(0, 0), cA, voffA); PG8_STAGE(PG8_SB(0, 1), cB + hstep, voffB); PG8_STAGE(PG8_SA(0, 1), cA + hstep, voffA);
        if (wr == 1) PG8_BAR;
        PG8_WAIT_V(4); PG8_BAR;
        PG8_STAGE(PG8_SB(1, 0), cB + kstep, voffB); PG8_STAGE(PG8_SA(1, 0), cA + kstep, voffA); PG8_STAGE(PG8_SB(1, 1), cB + hstep + kstep, voffB);
        PG8_WAIT_V(6); PG8_BAR;
    }
    for (;;) {
        const bool has_next = S.next(ui + 1, nxt);
        const char* nA = has_next ? (const char*)g.A + (size_t)nxt.pm * tstep + (size_t)nxt.kh * kslice : cA; const char* nB = has_next ? (const char*)g.Bt + (size_t)nxt.pn * tstep + (size_t)nxt.kh * kslice : cB;
        for (int t = 0; t < nt; t += 2) {
            const bool last = (t == nt - 2);
            const char* a1 = cA + (size_t)(t + 1) * kstep;
            const char* a2 = last ? nA : cA + (size_t)(t + 2) * kstep; const char* b2 = last ? nB : cB + (size_t)(t + 2) * kstep;
            const char* a3 = a2 + kstep; const char* b3 = b2 + kstep;
            if (last && has_next) S.a_ready(nxt);
            if constexpr (SP2) {
            PG8_LDB(B0, 0, 0); PG8_LDB(B1, 0, 1); PG8_SCHED; PG8_LDA(At, 0, 0); PG8_STAGE(PG8_SA(1, 1), a1 + hstep, voffA);
            PG8_WAIT_V(8); PG8_WAIT_L(0); PG8_BAR; PG8_MMA(0, 0, At, B0); PG8_MMA(0, 1, At, B1); PG8_BAR; PG8_SCHED;
            PG8_LDA(At, 0, 1); PG8_STAGE(PG8_SB(0, 0), b2, voffB); PG8_STAGE(PG8_SB(0, 1), b2 + hstep, voffB); PG8_STAGE(PG8_SA(0, 0), a2, voffA);
            PG8_WAIT_V(8); PG8_WAIT_L(0); PG8_BAR; PG8_MMA(1, 0, At, B0); PG8_MMA(1, 1, At, B1); PG8_BAR; PG8_SCHED;
            PG8_LDB(B0, 1, 0); PG8_LDB(B1, 1, 1); PG8_SCHED; PG8_LDA(At, 1, 0); PG8_STAGE(PG8_SA(0, 1), a2 + hstep, voffA);
            PG8_WAIT_V(8); PG8_WAIT_L(0); PG8_BAR; PG8_MMA(0, 0, At, B0); PG8_MMA(0, 1, At, B1); PG8_BAR; PG8_SCHED;
            PG8_LDA(At, 1, 1); PG8_STAGE(PG8_SB(1, 0), b3, voffB); PG8_STAGE(PG8_SB(1, 1), b3 + hstep, voffB); PG8_STAGE(PG8_SA(1, 0), a3, voffA);
            PG8_WAIT_V(8); PG8_WAIT_L(0); PG8_BAR; PG8_MMA(1, 0, At, B0); PG8_MMA(1, 1, At, B1); PG8_BAR; PG8_SCHED;
            } else {
            PG8_LDB(B0, 0, 0); PG8_SCHED; PG8_LDA(At, 0, 0); PG8_STAGE(PG8_SA(1, 1), a1 + hstep, voffA);
            PG8_WAIT_L(8); PG8_BAR; PG8_WAIT_L(0); PG8_MMA(0, 0, At, B0); PG8_BAR; PG8_SCHED;
            PG8_LDB(B1, 0, 1); PG8_STAGE(PG8_SB(0, 0), b2, voffB);
            PG8_BAR; PG8_WAIT_L(0); PG8_MMA(0, 1, At, B1); PG8_BAR;
            PG8_LDA(At, 0, 1); PG8_STAGE(PG8_SA(0, 0), a2, voffA);
            PG8_BAR; PG8_WAIT_L(0); PG8_MMA(1, 0, At, B0); PG8_BAR; PG8_SCHED;
            PG8_STAGE(PG8_SB(0, 1), b2 + hstep, voffB);
            PG8_WAIT_V(6); PG8_BAR; PG8_MMA(1, 1, At, B1); PG8_BAR;
            PG8_LDB(B0, 1, 0); PG8_SCHED; PG8_LDA(At, 1, 0); PG8_STAGE(PG8_SA(0, 1), a2 + hstep, voffA);
            PG8_WAIT_L(8); PG8_BAR; PG8_WAIT_L(0); PG8_MMA(0, 0, At, B0); PG8_BAR; PG8_SCHED;
            PG8_LDB(B1, 1, 1); PG8_STAGE(PG8_SB(1, 0), b3, voffB);
            PG8_BAR; PG8_WAIT_L(0); PG8_MMA(0, 1, At, B1); PG8_BAR;
            PG8_LDA(At, 1, 1); PG8_STAGE(PG8_SA(1, 0), a3, voffA);
            PG8_BAR; PG8_WAIT_L(0); PG8_MMA(1, 0, At, B0); PG8_BAR; PG8_SCHED;
            PG8_STAGE(PG8_SB(1, 1), b3 + hstep, voffB);
            PG8_WAIT_V(6); PG8_BAR; PG8_MMA(1, 1, At, B1); PG8_BAR;
            }
        }
        if constexpr (ALIGN_EPI) { if (wr == 0) PG8_BAR; }
        if constexpr (!Epi::AFTER_DRAIN) { E(acc, cur, wr, wc, fr, fq); S.done(cur); }
        if (!has_next) break;
        if (!(Epi::MID && cur.kh == 0)) {
#pragma unroll
        for (int a = 0; a < 2; ++a)
#pragma unroll
            for (int b = 0; b < 2; ++b)
#pragma unroll
                for (int m = 0; m < 4; ++m)
#pragma unroll
                    for (int n = 0; n < 2; ++n) acc[a][b][m][n] = (f32x4){0.f, 0.f, 0.f, 0.f};
        }
        cur = nxt; cA = nA; cB = nB; ++ui;
        if constexpr (ALIGN_EPI) { if (wr == 1) PG8_BAR; }
    }
    PG8_WAIT_V(0);
    if constexpr (!ALIGN_EPI) { if (wr == 0) PG8_BAR; }
    PG8_BAR;
    if constexpr (Epi::AFTER_DRAIN) { E.fused(acc, cur, wr, wc, fr, fq, lds, wid, lane); S.done(cur); }
#undef PG8_SA
#undef PG8_SB
#undef PG8_STAGE
#undef PG8_LDA
#undef PG8_LDB
#undef PG8_MMA
#undef PG8_WAIT_V
#undef PG8_WAIT_L
#undef PG8_BAR
#undef PG8_SCHED
}
}

namespace attn {
constexpr int D = 128;
constexpr float THR = 8.f;
constexpr bool WSKIP = false;
constexpr int LDP = 16384, LDO = 2048;
constexpr float SCALE = 0.08838834764831845f;
constexpr int NW = 8, QBLK = 32, KVBLK = 64, QB = NW * QBLK;
constexpr int SHM_V = KVBLK * D * 2, SHM_K = KVBLK * D * 2;
constexpr int LDS_BYTES = 2 * SHM_V + 2 * SHM_K + NW * 64 * 4;

using bf16 = __hip_bfloat16;
typedef short bf16x8 __attribute__((ext_vector_type(8)));
typedef short s16x4 __attribute__((ext_vector_type(4)));
typedef float f32x16 __attribute__((ext_vector_type(16)));
typedef float f32x4 __attribute__((ext_vector_type(4)));
typedef unsigned u32x4 __attribute__((ext_vector_type(4)));
template <class A, class Bt> struct same_t { static constexpr bool v = false; };
template <class A> struct same_t<A, A> { static constexpr bool v = true; };

#define KSWZ(row, colB) ((row) * 256 + ((colB) ^ (((row) & 7) << 4)))
#define SBAR() __builtin_amdgcn_sched_barrier(0)
__device__ __forceinline__ int v_st(int k, int c) { const int kk = (k & ~0xC) | ((k & 4) << 1) | ((k & 8) >> 1); return ((kk >> 3) * 4 + (c >> 5)) * 512 + ((kk & 7) * 32 + (c & 31)) * 2; }
__device__ __forceinline__ int v_rd_base(int lane) { return ((lane & 3) << 3) | (((lane >> 2) & 3) << 6) | (((lane >> 4) & 1) << 5) | (((lane >> 5) & 1) << 8); }
constexpr int v_rd_off(int d0, int ks, int half) { return d0 * 512 + ks * 4096 + half * 2048; }
__device__ __forceinline__ int crow(int r, int hi) { return (r & 3) + 8 * (r >> 2) + 4 * hi; }
__device__ __forceinline__ unsigned cvtpk(float lo, float hi) {
    unsigned r; asm volatile("v_cvt_pk_bf16_f32 %0, %1, %2" : "=v"(r) : "v"(lo), "v"(hi)); return r;
}
__device__ __forceinline__ bf16x8 pack8(f32x4 a, f32x4 b) {
    u32x4 w = {cvtpk(a[0], a[1]), cvtpk(a[2], a[3]), cvtpk(b[0], b[1]), cvtpk(b[2], b[3])};
    return *reinterpret_cast<bf16x8*>(&w);
}
template <class T> __device__ __forceinline__ bf16x8 load8(const T* p) {
    if constexpr (same_t<T, float>::v) { return pack8(*(const f32x4*)p, *(const f32x4*)(p + 4)); }
    else { return *reinterpret_cast<const bf16x8*>(p); }
}
__device__ __forceinline__ void mask_tile(f32x16& p0, f32x16& p1, int dq, unsigned W) {
    const float NEG = -__builtin_inff();
#pragma unroll
    for (int r = 0; r < 16; ++r) {
        const int c = (r & 3) + 8 * (r >> 2);
        if ((unsigned)(dq - c) >= W) p0[r] = NEG;
        if ((unsigned)(dq - c - 32) >= W) p1[r] = NEG;
    }
}
__device__ __forceinline__ void partialSM(f32x16& p0, f32x16& p1, float& m_reg, float& mn, float& alpha) {
    float pmax = p0[0]; for (int r = 1; r < 16; ++r) pmax = fmaxf(pmax, p0[r]); for (int r = 0; r < 16; ++r) pmax = fmaxf(pmax, p1[r]);
    { auto rr = __builtin_amdgcn_permlane32_swap(__float_as_uint(pmax), __float_as_uint(pmax), false, false);
      pmax = fmaxf(__uint_as_float(rr[0]), __uint_as_float(rr[1])); }
    constexpr float C2 = 1.4426950408889634f * SCALE;
    if (__builtin_expect(__all((pmax - m_reg) * SCALE <= THR), 1)) { mn = m_reg; alpha = 1.f; }
    else { mn = fmaxf(m_reg, pmax); alpha = __builtin_amdgcn_exp2f((m_reg - mn) * C2); m_reg = mn; }
    const float mnL = -mn * C2;
    for (int r = 0; r < 16; ++r) p0[r] = fmaf(p0[r], C2, mnL); for (int r = 0; r < 16; ++r) p1[r] = fmaf(p1[r], C2, mnL);
    for (int r = 0; r < 16; ++r) p0[r] = __builtin_amdgcn_exp2f(p0[r]);
}
__device__ __forceinline__ void finishSM(f32x16& p0, f32x16& p1, float alpha, float& l_reg, bf16x8& pa0, bf16x8& pa1, bf16x8& pa2, bf16x8& pa3) {
    for (int r = 0; r < 16; ++r) p1[r] = __builtin_amdgcn_exp2f(p1[r]);
    float ps = 0; for (int r = 0; r < 16; ++r) ps += p0[r]; for (int r = 0; r < 16; ++r) ps += p1[r];
    { auto rr = __builtin_amdgcn_permlane32_swap(__float_as_uint(ps), __float_as_uint(ps), false, false);
      ps = __uint_as_float(rr[0]) + __uint_as_float(rr[1]); }
    l_reg = l_reg * alpha + ps;
#define PK4(P, B_, OUT) do { unsigned a0 = cvtpk(P[B_+0], P[B_+1]), a1 = cvtpk(P[B_+2], P[B_+3]);                          \
        unsigned b0 = cvtpk(P[B_+4], P[B_+5]), b1 = cvtpk(P[B_+6], P[B_+7]);                                             \
        auto r0 = __builtin_amdgcn_permlane32_swap(a0, b0, false, false); auto r1 = __builtin_amdgcn_permlane32_swap(a1, b1, false, false); \
        u32x4 w = {r0[0], r1[0], r0[1], r1[1]}; OUT = *reinterpret_cast<bf16x8*>(&w); } while (0)
    PK4(p0, 0, pa0); PK4(p0, 8, pa1); PK4(p1, 0, pa2); PK4(p1, 8, pa3);
#undef PK4
}
template <int KB, bool SK>
__device__ __forceinline__ void qkt(f32x16& p0, f32x16& p1, const char* K_lds, int r32, int hi, const bf16x8* qr, bool act) {
    if (SK && !act) { const float NEG = -__builtin_inff();
#pragma unroll
        for (int r = 0; r < 16; ++r) { p0[r] = NEG; p1[r] = NEG; } return; }
    p0 = f32x16{}; p1 = f32x16{};
    const char* kb[4];
#pragma unroll
    for (int dd = 0; dd < 4; ++dd) kb[dd] = K_lds + KB * SHM_K + KSWZ(r32, (dd * 16 + hi * 8) * 2);
#pragma unroll
    for (int d0 = 0; d0 < 8; ++d0) { const char* a = kb[d0 & 3] + (d0 >> 2) * 128;
        bf16x8 b0 = *reinterpret_cast<const bf16x8*>(a);
        bf16x8 b1 = *reinterpret_cast<const bf16x8*>(a + 32 * 256);
        p0 = __builtin_amdgcn_mfma_f32_32x32x16_bf16(b0, qr[d0], p0, 0, 0, 0);
        p1 = __builtin_amdgcn_mfma_f32_32x32x16_bf16(b1, qr[d0], p1, 0, 0, 0); }
}
template <int VB, bool SK>
__device__ __forceinline__ void pv_tile(f32x16* o, int vb0, bf16x8 pa0, bf16x8 pa1, bf16x8 pa2, bf16x8 pa3, bool act) {
    if (SK && !act) return;
#define TRRD(dst, off) asm volatile("ds_read_b64_tr_b16 %0, %1 offset:%2" : "=&v"(dst) : "v"(vb0), "i"(off) : "memory")
#define PV_D0(d0) do { s16x4 l0, l1, l2, l3, h0, h1, h2, h3; constexpr int b_ = VB * SHM_V + v_rd_off(d0, 0, 0);     \
        TRRD(l0, b_); TRRD(h0, b_ + 2048); TRRD(l1, b_ + 4096); TRRD(h1, b_ + 6144); TRRD(l2, b_ + 8192); TRRD(h2, b_ + 10240); TRRD(l3, b_ + 12288); TRRD(h3, b_ + 14336); \
        asm volatile("s_waitcnt lgkmcnt(0)" ::: "memory"); SBAR();                 \
        o[d0] = __builtin_amdgcn_mfma_f32_32x32x16_bf16(pa0, (bf16x8){l0[0], l0[1], l0[2], l0[3], h0[0], h0[1], h0[2], h0[3]}, o[d0], 0, 0, 0);   \
        o[d0] = __builtin_amdgcn_mfma_f32_32x32x16_bf16(pa1, (bf16x8){l1[0], l1[1], l1[2], l1[3], h1[0], h1[1], h1[2], h1[3]}, o[d0], 0, 0, 0);   \
        o[d0] = __builtin_amdgcn_mfma_f32_32x32x16_bf16(pa2, (bf16x8){l2[0], l2[1], l2[2], l2[3], h2[0], h2[1], h2[2], h2[3]}, o[d0], 0, 0, 0);   \
        o[d0] = __builtin_amdgcn_mfma_f32_32x32x16_bf16(pa3, (bf16x8){l3[0], l3[1], l3[2], l3[3], h3[0], h3[1], h3[2], h3[3]}, o[d0], 0, 0, 0); } while (0)
    PV_D0(0); PV_D0(1); PV_D0(2); PV_D0(3);
#undef PV_D0
#undef TRRD
}

template <class TIn, class TOut> struct BlockRef { const TIn* Q; const TIn* K; const TIn* V; TOut* O; int P0; };
template <class TIn> struct Seam {
    bf16x8 qr[8];
    bf16x8 st_v0, st_v1, st_k0, st_k1; f32x4 sf0, sf1, sf2, sf3;
    f32x4 tq[16];
};
__device__ __forceinline__ int swa_jlo(int P0, int W) { const int lowk = P0 - W + 1; return lowk > 0 ? lowk / KVBLK : 0; }
#define ROW(p, k0, rr) ((p) + (size_t)((k0) + (rr)) * LDP + sc)
#define VMW() asm volatile("s_waitcnt vmcnt(0)" ::: "memory")
#define VMWN(n) asm volatile("s_waitcnt vmcnt(%0)" :: "i"(n) : "memory")
#define UPTR(p, off) ((const TIn*)((const char*)(p) + (unsigned)(off)))
#define SLOAD_H(Kp, Vp, k0) do { const TIn* kb_ = (Kp) + (size_t)(k0) * LDP; const TIn* vb_ = (Vp) + (size_t)(k0) * LDP;                     \
                         S.st_v0 = load8<TIn>(UPTR(vb_, toff)); S.st_v1 = load8<TIn>(UPTR(vb_ + 32 * LDP, toff));              \
                         S.st_k0 = load8<TIn>(UPTR(kb_, toff)); S.st_k1 = load8<TIn>(UPTR(kb_ + 32 * LDP, toff)); } while (0)
#define SWRITE_HK(bf) do { *(bf16x8*)(K_lds + (bf) * SHM_K + kws) = S.st_k0; *(bf16x8*)(K_lds + (bf) * SHM_K + kws + 32 * 256) = S.st_k1; } while (0)
#define SWRITE_HV(bf) do { *(bf16x8*)(V_lds + (bf) * SHM_V + vst0) = S.st_v0; *(bf16x8*)(V_lds + (bf) * SHM_V + vst1) = S.st_v1; } while (0)
#define SWRITE_H(bf) do { SWRITE_HV(bf); SWRITE_HK(bf); } while (0)
#define SLOAD_F(p, k0) do { S.sf0 = *(const f32x4*)ROW(p, k0, sr); S.sf1 = *(const f32x4*)(ROW(p, k0, sr) + 4);                \
                            S.sf2 = *(const f32x4*)ROW(p, k0, 32 + sr); S.sf3 = *(const f32x4*)(ROW(p, k0, 32 + sr) + 4); } while (0)
#define SWRITE_KF(bf) do { *(bf16x8*)(K_lds + (bf) * SHM_K + kws) = pack8(S.sf0, S.sf1); *(bf16x8*)(K_lds + (bf) * SHM_K + kws + 32 * 256) = pack8(S.sf2, S.sf3); } while (0)
#define SWRITE_VF(bf) do { *(bf16x8*)(V_lds + (bf) * SHM_V + vst0) = pack8(S.sf0, S.sf1); *(bf16x8*)(V_lds + (bf) * SHM_V + vst1) = pack8(S.sf2, S.sf3); } while (0)
template <class TIn, class TOut>
__device__ __forceinline__ void causal_swa_prime(const BlockRef<TIn, TOut>& cur, int W, char* lds, Seam<TIn>& S) {
    constexpr bool F32 = same_t<TIn, float>::v;
    const int tid = tidx(), wid = __builtin_amdgcn_readfirstlane(tid >> 6), lane = tid & 63, r32 = lane & 31, hi = lane >> 5;
    const int sr = tid >> 4, sc = (tid & 15) * 8, kws = KSWZ(sr, sc * 2); char* K_lds = lds + 2 * SHM_V; const unsigned toff = (unsigned)(sr * LDP + sc) * 2u;
    const int kb0 = swa_jlo(cur.P0, W) * KVBLK;
    for (int d0 = 0; d0 < 8; ++d0) S.qr[d0] = load8<TIn>(UPTR(cur.Q + (size_t)(wid * QBLK) * LDP + d0 * 16, (unsigned)(r32 * LDP + hi * 8) * 2u));
    if constexpr (F32) { SLOAD_F((const float*)cur.K, kb0); VMW(); SWRITE_KF(0); SBAR(); SLOAD_F((const float*)cur.V, kb0); }
    else { SLOAD_H(cur.K, cur.V, kb0); VMW(); SWRITE_HK(0); }
    __syncthreads();
}
template <class TIn, class TOut>
__device__ __forceinline__ void causal_swa_block(const BlockRef<TIn, TOut>& cur, const BlockRef<TIn, TOut>& nxt, int skv, int W, char* lds, Seam<TIn>& S) {
    constexpr bool F32 = same_t<TIn, float>::v;
    const int tid = tidx(), wid = __builtin_amdgcn_readfirstlane(tid >> 6), lane = tid & 63, r32 = lane & 31, hi = lane >> 5;
    const int j_lo = swa_jlo(cur.P0, W);
    int j_hi = (cur.P0 + QB - 1) / KVBLK + 1; if (j_hi > skv / KVBLK) j_hi = skv / KVBLK;
    const int NT = j_hi - j_lo;
    const int kbn = swa_jlo(nxt.P0, W) * KVBLK;
    const int qlo = cur.P0 + wid * QBLK, qm = qlo + r32 - 4 * hi;
    char* V_lds = lds; char* K_lds = lds + 2 * SHM_V;
    float* ws = (float*)(lds + 2 * SHM_V + 2 * SHM_K) + wid * 64; float* li_l = ws, * al_l = ws + 32;
    float m_reg = -1e30f, l_reg = 0; f32x16 o[4] = {};
    const int sr = tid >> 4, sc = (tid & 15) * 8, vst0 = v_st(sr, sc), vst1 = vst0 + 8192  , kws = KSWZ(sr, sc * 2); const unsigned toff = (unsigned)(sr * LDP + sc) * 2u;
    const int vb0 = (int)(uintptr_t)V_lds + v_rd_base(lane);
    const TIn* Kh = cur.K; const TIn* Vh = cur.V;
#define RESC(a) do { if (__any((a) < 1.f)) { if (hi == 0) al_l[r32] = (a); asm volatile("s_waitcnt lgkmcnt(0)" ::: "memory");              \
                     for (int d_ = 0; d_ < 4; ++d_) for (int r = 0; r < 16; ++r) o[d_][r] *= al_l[crow(r, hi)]; } } while (0)
#define KBASE(t) ((j_lo + (t)) * KVBLK)
#define ACT(t) (KBASE(t) <= qlo + QBLK - 1 && KBASE(t) + KVBLK - 1 >= qlo - W + 1)
#define MASKT(P0_, P1_, t) do { const int kb_ = KBASE(t); if ((!SK || ACT(t)) && (kb_ + KVBLK - 1 > qlo || kb_ <= qlo + QBLK - 1 - W)) mask_tile(P0_, P1_, qm - kb_, (unsigned)W); } while (0)
    constexpr int NQL = F32 ? 16 : 8;
    constexpr bool SK = WSKIP && !F32;
#define SEAM_K0() do { VMWN(NQL); if constexpr (F32) { SWRITE_KF(0); SBAR(); SLOAD_F((const float*)nxt.V, kbn); } else { SWRITE_HK(0); } SBAR(); } while (0)
    f32x16 pA0, pA1, pB0, pB1; float mnA, mnB, alA, alB; bf16x8 pa0, pa1, pa2, pa3;
    if constexpr (F32) { VMW(); SWRITE_VF(0); SBAR(); } else { SWRITE_HV(0); SBAR(); }
    if (NT > 1) { if constexpr (F32) SLOAD_F((const float*)Kh, KBASE(1)); else SLOAD_H(Kh, Vh, KBASE(1)); }
    SBAR(); qkt<0, SK>(pA0, pA1, K_lds, r32, hi, S.qr, ACT(0));
    if constexpr (F32) { if (NT > 1) { VMW(); SWRITE_KF(1); SBAR(); SLOAD_F((const float*)Vh, KBASE(1)); } }
    MASKT(pA0, pA1, 0); partialSM(pA0, pA1, m_reg, mnA, alA);
    if (NT > 1) { VMW(); if constexpr (F32) { SWRITE_VF(1); SBAR(); if (NT > 2) SLOAD_F((const float*)Kh, KBASE(2)); } else SWRITE_H(1); }
    __syncthreads();
#define HALF_STEP(PX0, PX1, mnX, alX, PY0, PY1, alY, t, KB, VB, SB) do {                                                      \
        SBAR(); qkt<KB, SK>(PX0, PX1, K_lds, r32, hi, S.qr, ACT(t));                                             \
        finishSM(PY0, PY1, alY, l_reg, pa0, pa1, pa2, pa3); SBAR();                                                           \
        if ((t) + 1 < NT) { if constexpr (F32) { VMW(); SWRITE_KF(SB); SBAR(); SLOAD_F((const float*)Vh, KBASE((t) + 1)); }  \
                            else { SLOAD_H(Kh, Vh, KBASE((t) + 1)); } SBAR(); }                                               \
        pv_tile<VB, SK>(o, vb0, pa0, pa1, pa2, pa3, ACT((t) - 1)); MASKT(PX0, PX1, (t)); partialSM(PX0, PX1, m_reg, mnX, alX);                                        \
        __syncthreads();                                                                                                      \
        if ((t) + 1 < NT) { VMW(); if constexpr (F32) { SWRITE_VF(SB); SBAR(); if ((t) + 2 < NT) SLOAD_F((const float*)Kh, KBASE((t) + 2)); } \
                            else { SWRITE_H(SB); } }                                                                          \
        RESC(alX); __syncthreads(); } while (0)
    for (int t = 1; t + 1 < NT; t += 2) {
        HALF_STEP(pB0, pB1, mnB, alB, pA0, pA1, alA, t, 1, 0, 0);
        HALF_STEP(pA0, pA1, mnA, alA, pB0, pB1, alB, t + 1, 0, 1, 1);
    }
    const bool even = (NT & 1) == 0;
    if (even) { SBAR(); qkt<1, SK>(pB0, pB1, K_lds, r32, hi, S.qr, ACT(NT - 1)); SBAR(); }
#define QROW(e) (nxt.Q + (size_t)(wid * QBLK + r32) * LDP + ((e) >> 1) * 16 + hi * 8 + ((e) & 1) * 4)
    if constexpr (F32) { SLOAD_F((const float*)nxt.K, kbn); SBAR();
#pragma unroll
        for (int e = 0; e < 8; ++e) S.tq[e] = *(const f32x4*)QROW(e); }
    else { SLOAD_H(nxt.K, nxt.V, kbn); SBAR();
#pragma unroll
        for (int d0 = 0; d0 < 8; ++d0) S.qr[d0] = load8<TIn>(UPTR(nxt.Q + (size_t)(wid * QBLK) * LDP + d0 * 16, (unsigned)(r32 * LDP + hi * 8) * 2u)); }
    SBAR();
    finishSM(pA0, pA1, alA, l_reg, pa0, pa1, pa2, pa3); SBAR();
    if constexpr (F32) {
#pragma unroll
        for (int e = 8; e < 16; ++e) S.tq[e] = *(const f32x4*)QROW(e); SBAR(); }
#undef QROW
    pv_tile<0, SK>(o, vb0, pa0, pa1, pa2, pa3, ACT(even ? NT - 2 : NT - 1));
    if (even) { MASKT(pB0, pB1, NT - 1); partialSM(pB0, pB1, m_reg, mnB, alB); __syncthreads(); RESC(alB);
        finishSM(pB0, pB1, alB, l_reg, pa0, pa1, pa2, pa3); SBAR(); pv_tile<1, SK>(o, vb0, pa0, pa1, pa2, pa3, ACT(NT - 1)); }
    SBAR(); SEAM_K0();
    if (hi == 0) li_l[r32] = l_reg; asm volatile("s_waitcnt lgkmcnt(0)" ::: "memory");
    float rli[16];
#pragma unroll
    for (int r = 0; r < 16; ++r) rli[r] = __builtin_amdgcn_rcpf(li_l[crow(r, hi)]);
    TOut* Ow = cur.O + (size_t)(wid * QBLK) * LDO;
#pragma unroll
    for (int r = 0; r < 16; ++r) { const int orow = crow(r, hi);
#pragma unroll
        for (int d0 = 0; d0 < 4; ++d0) { const float v = o[d0][r] * rli[r];
            if constexpr (same_t<TOut, float>::v) { Ow[(size_t)orow * LDO + d0 * 32 + r32] = v; }
            else { const float vn = __shfl_xor(v, 1);
                   if ((r32 & 1) == 0) *(unsigned*)(Ow + (size_t)orow * LDO + d0 * 32 + r32) = cvtpk(v, vn); } } }
    if constexpr (F32) {
#pragma unroll
        for (int d0 = 0; d0 < 8; ++d0) S.qr[d0] = pack8(S.tq[2 * d0], S.tq[2 * d0 + 1]); }
    __syncthreads();
#undef RESC
#undef KBASE
#undef ACT
#undef MASKT
#undef SEAM_K0
#undef HALF_STEP
}
#undef ROW
#undef VMW
#undef VMWN
#undef SLOAD_H
#undef UPTR
#undef SWRITE_HK
#undef SWRITE_HV
#undef SWRITE_H
#undef SLOAD_F
#undef SWRITE_KF
#undef SWRITE_VF

#undef KSWZ
#undef SBAR
}

#define GAS __attribute__((address_space(1)))
#define LAS __attribute__((address_space(3)))
typedef unsigned short bf16;
typedef unsigned v4u __attribute__((ext_vector_type(4)));
typedef float f32x4 __attribute__((ext_vector_type(4)));
typedef short bf16x8 __attribute__((ext_vector_type(8)));
typedef GAS unsigned gu32;
typedef GAS unsigned long long gu64;
#define RLX_AGENT __ATOMIC_RELAXED, __HIP_MEMORY_SCOPE_AGENT
#define LDS_WAIT() asm volatile("s_waitcnt lgkmcnt(0)" ::: "memory")
#define VM_WAIT() asm volatile("s_waitcnt vmcnt(0)" ::: "memory")
__device__ __forceinline__ unsigned long long rt() { return __builtin_amdgcn_s_memrealtime(); }
__device__ __forceinline__ unsigned f2bf(float f) { unsigned u = __builtin_bit_cast(unsigned, f); return (u + 0x7fffu + ((u >> 16) & 1u)) >> 16; }
__device__ __forceinline__ unsigned pk2(float lo, float hi) { return f2bf(lo) | (f2bf(hi) << 16); }

#define XB_TMO      128
#define XB_XCNT(j)  (256  + 64 * (j))
#define XB_XSUB(j)  (1280 + 64 * (j))
#define XB_XGEN(j)  (2304 + 64 * (j))
#define XB_TOP      3328
#define XB_TOPGEN   3392
#define XCD_BAR_WORDS 3456
#define XB_SPIN_CAP (1u << 18)

__device__ __forceinline__ unsigned xb_ld(unsigned* p)              { return __hip_atomic_load(p, __ATOMIC_RELAXED, __HIP_MEMORY_SCOPE_AGENT); }
__device__ __forceinline__ unsigned xb_add(unsigned* p, unsigned v) { return __hip_atomic_fetch_add(p, v, __ATOMIC_RELAXED, __HIP_MEMORY_SCOPE_AGENT); }
__device__ __forceinline__ unsigned xb_xcc_id() { return (unsigned)__builtin_amdgcn_s_getreg((3 << 11) | 20) & 0xFu; }
#define XB_SPIN(cond, bar) do { unsigned _sp = 0; while (cond) { __builtin_amdgcn_s_sleep(1); \
    if ((++_sp & 255u) == 0u) { if (xb_ld(&(bar)[XB_TMO])) break; if (_sp > XB_SPIN_CAP) { atomicAdd(&(bar)[XB_TMO], 1u); break; } } } } while (0)

struct XcdBarrier {
    unsigned* bar; unsigned x;
    volatile LAS unsigned* st;
};

__device__ __forceinline__ XcdBarrier xcd_barrier_post(unsigned* bar, volatile LAS unsigned* st) {
    XcdBarrier b; b.bar = bar; b.x = xb_xcc_id(); b.st = st;
    if (threadIdx.x == 0) (void)xb_add(&bar[XB_XCNT(b.x)], 1u);
    return b;
}
__device__ __forceinline__ void xcd_barrier_complete(unsigned* bar, unsigned x, unsigned& nloc, unsigned& nx) {
    const unsigned G = gridDim.x * gridDim.y * gridDim.z;
    unsigned sum, cnt, mine, sp = 0u;
    for (;;) {
        sum = 0u; cnt = 0u; mine = 0u;
#pragma unroll
        for (unsigned j = 0; j < 16; ++j) { const unsigned c = xb_ld(&bar[XB_XCNT(j)]); sum += c; cnt += (c > 0u) ? 1u : 0u; mine = (j == x) ? c : mine; }
        if (sum == G) break;
        __builtin_amdgcn_s_sleep(1);
        if ((++sp & 255u) == 0u) { if (xb_ld(&bar[XB_TMO])) break; if (sp > XB_SPIN_CAP) { atomicAdd(&bar[XB_TMO], 1u); break; } }
    }
    nloc = mine > 0u ? mine : 1u; nx = cnt > 0u ? cnt : 1u;
}

__device__ __forceinline__ void xcd_barrier(const XcdBarrier& b) {
    asm volatile("s_waitcnt vmcnt(0)" ::: "memory");
    __syncthreads();
    if (threadIdx.x == 0) {
        unsigned* bar = b.bar;
        __builtin_amdgcn_s_waitcnt(0);
        unsigned nloc = b.st[0], nx = b.st[1];
        if (nloc == 0u) { xcd_barrier_complete(bar, b.x, nloc, nx); b.st[0] = nloc; b.st[1] = nx; }
        const unsigned old = xb_add(&bar[XB_XSUB(b.x)], 1u);
        const unsigned gen = old / nloc;
        if (old + 1u == (gen + 1u) * nloc) {
            __builtin_amdgcn_fence(__ATOMIC_RELEASE, "agent");
            asm volatile("s_waitcnt vmcnt(0)" ::: "memory");
            const unsigned og = xb_add(&bar[XB_TOP], 1u);
            const unsigned tg = og / nx;
            if (og + 1u == (tg + 1u) * nx) xb_add(&bar[XB_TOPGEN], 1u);
            else XB_SPIN(xb_ld(&bar[XB_TOPGEN]) == tg, bar);
            __builtin_amdgcn_fence(__ATOMIC_ACQUIRE, "agent");
            xb_add(&bar[XB_XGEN(b.x)], 1u);
            asm volatile("s_waitcnt vmcnt(0)" ::: "memory");
        } else {
            XB_SPIN(xb_ld(&bar[XB_XGEN(b.x)]) == gen, bar);
            __builtin_amdgcn_fence(__ATOMIC_ACQUIRE, "agent");
            asm volatile("s_waitcnt vmcnt(0)" ::: "memory");
        }
    }
    __syncthreads();
}

constexpr int DM = 2048, NBATCH = 4, SEQ = 4096, DEPTH = 4, MTOK = NBATCH * SEQ;
constexpr int N_IN = 16400, NP = 16384, DFF = 5632, NHEAD = 8;
constexpr float EPS = 1e-6f;
constexpr int C_MQ = 0, C_MK = 1024, C_MV = 2048, C_MO = 4096, C_DQ = 6144, C_DK = 8192, C_DV = 10240, C_GM = 12288, C_GD = 14336;
constexpr int SRC_GATE = 6144;

constexpr size_t MiB = 1u << 20;
constexpr size_t WS_CTL = 0, CTL_ZERO_BYTES = 1 * MiB;
constexpr size_t WS_W1 = 1 * MiB;
constexpr size_t WS_W2 = 65 * MiB;
constexpr size_t WS_W3 = 81 * MiB;
constexpr size_t WS_W4 = 89 * MiB;
constexpr size_t WS_W5 = 133 * MiB;
constexpr size_t WS_X = 156 * MiB;
constexpr size_t WS_HB = 284 * MiB;
constexpr size_t WS_G = 348 * MiB;
constexpr size_t WS_QKC = 349 * MiB;
constexpr size_t WS_HMF = 413 * MiB;
constexpr size_t WS_HD1 = 541 * MiB;
constexpr size_t WS_HD2 = 669 * MiB;
constexpr size_t WS_HMD = 797 * MiB;
constexpr size_t WS_Y = 925 * MiB;
constexpr size_t WS_P = 989 * MiB;
constexpr size_t WS_END = 1501 * MiB;
constexpr int CW_BAR = 4096;

constexpr int RING_BYTES = 131072, LDSCTL_OFF = RING_BYTES, MISC_OFF = LDSCTL_OFF + 320, PTR_OFF = LDSCTL_OFF + 1024, LDS_BYTES = 147456;
constexpr int NWAVES = 8, NTHREADS = NWAVES * 64;
constexpr int MLSTM_WGS = 32;

__device__ __forceinline__ float bfbits2f(unsigned short h) { return __uint_as_float((unsigned)h << 16); }
__device__ __forceinline__ float wlo(unsigned w) { return __uint_as_float(w << 16); }
__device__ __forceinline__ float whi(unsigned w) { return __uint_as_float(w & 0xffff0000u); }
__device__ __forceinline__ float wave_sum(float v) {
#pragma unroll
    for (int o = 1; o < 64; o <<= 1) v += __shfl_xor(v, o);
    return v;
}
__device__ __forceinline__ float sigm(float x) { return 1.0f / (1.0f + __expf(-x)); }
__device__ __forceinline__ float lam_init_of(int l) { return 0.8f - 0.6f * __expf(-0.3f * (float)l); }

__device__ __forceinline__ void tr_item(const float* W, int ldw, int scol0, int k0, const float* scale, float smul, bf16* WT, int ldt, LAS float* scr, int lane) {
#pragma unroll 8
    for (int i = 0; i < 32; ++i) { const int kk = 2 * i + (lane >> 5); float v = W[(size_t)(k0 + kk) * ldw + scol0 + (lane & 31)]; if (scale) v *= scale[k0 + kk] * smul; scr[kk * 33 + (lane & 31)] = v; }
    LDS_WAIT(); asm volatile("" ::: "memory");
    const int c = lane & 7;
#pragma unroll
    for (int j = 0; j < 4; ++j) { const int n = (lane >> 3) + 8 * j; const LAS float* s = scr + (8 * c) * 33 + n;
        v4u o; o.x = pk2(s[0 * 33], s[1 * 33]); o.y = pk2(s[2 * 33], s[3 * 33]); o.z = pk2(s[4 * 33], s[5 * 33]); o.w = pk2(s[6 * 33], s[7 * 33]);
        *(GAS v4u*)(WT + (size_t)n * ldt + k0 + 8 * c) = o; }
    LDS_WAIT(); asm volatile("" ::: "memory");
}

struct Args {
    const float* in[21]; float* out; unsigned char* ws;
    int l_lo, l_hi, ph_lo, ph_hi, do_final, use_bar, pad0, pad1;
};
struct DArgs { LAS unsigned char* L; int l_lo, l_hi, ph_lo, ph_hi, do_final, use_bar; };
__device__ __forceinline__ unsigned long long ptr_get(const DArgs& A, int i) {
    const unsigned long long v = ((const volatile LAS unsigned long long*)(A.L + PTR_OFF))[i];
    const unsigned lo = __builtin_amdgcn_readfirstlane((unsigned)v), hi = __builtin_amdgcn_readfirstlane((unsigned)(v >> 32));
    return ((unsigned long long)hi << 32) | lo;
}
__device__ __forceinline__ const float* inp(const DArgs& A, int i) { return (const float*)(const GAS float*)ptr_get(A, i); }
__device__ __forceinline__ float* outp(const DArgs& A) { return (float*)(GAS float*)ptr_get(A, 21); }
__device__ __forceinline__ unsigned char* wsp(const DArgs& A) { return (unsigned char*)(GAS unsigned char*)ptr_get(A, 22); }

__device__ __forceinline__ void phase_weights(const DArgs& A, int l, LAS unsigned char* lds, int gw, int NGW, int wave, int lane) {
    LAS float* scr = (LAS float*)(lds + wave * 8448);
    unsigned char* ws = wsp(A);
    const float* w_in = inp(A, 2) + (size_t)l * DM * N_IN; const float* attn_nw = inp(A, 1) + (size_t)l * DM;
    const float* w_bm = inp(A, 13) + (size_t)l * DM * DM; const float* w_bd = inp(A, 14) + (size_t)l * DM * DM; const float* w_o = inp(A, 15) + (size_t)l * DM * DM;
    const float* m_nw = inp(A, 7) + (size_t)l * DM; const float* d_nw = inp(A, 12) + (size_t)l * DM; const float* f_nw = inp(A, 16) + (size_t)l * DM;
    const float* w_g = inp(A, 17) + (size_t)l * DM * DFF; const float* w_u = inp(A, 18) + (size_t)l * DM * DFF; const float* w_d = inp(A, 19) + (size_t)l * DFF * DM;
    bf16* W1 = (bf16*)(ws + WS_W1); bf16* W2 = (bf16*)(ws + WS_W2); bf16* W3 = (bf16*)(ws + WS_W3); bf16* W4 = (bf16*)(ws + WS_W4); bf16* W5 = (bf16*)(ws + WS_W5);
    constexpr int I1 = (DM / 64) * (NP / 32), I2 = (DM / 64) * (DM / 32), I4 = (DM / 64) * (2 * DFF / 32), I5 = (DFF / 64) * (DM / 32);
    constexpr int NITEMS = I1 + 3 * I2 + I4 + I5;
    const float one_m_lam = 1.0f - lam_init_of(l);
    for (int it = gw; it < NITEMS; it += NGW) {
        int r = it;
        if (r < I1) { const int nblk = NP / 32, kb = r / nblk, nb = r % nblk, n0 = 32 * nb; tr_item(w_in, N_IN, n0 + (n0 >= SRC_GATE ? 16 : 0), 64 * kb, attn_nw, 1.0f, W1 + (size_t)n0 * DM, DM, scr, lane); continue; } r -= I1;
        if (r < I2) { const int nblk = DM / 32, kb = r / nblk, nb = r % nblk, n0 = 32 * nb; tr_item(w_bm, DM, n0, 64 * kb, m_nw, 1.0f, W2 + (size_t)n0 * (2 * DM), 2 * DM, scr, lane); continue; } r -= I2;
        if (r < I2) { const int nblk = DM / 32, kb = r / nblk, nb = r % nblk, n0 = 32 * nb; tr_item(w_bd, DM, n0, 64 * kb, d_nw, one_m_lam, W2 + (size_t)n0 * (2 * DM) + DM, 2 * DM, scr, lane); continue; } r -= I2;
        if (r < I2) { const int nblk = DM / 32, kb = r / nblk, nb = r % nblk, n0 = 32 * nb; tr_item(w_o, DM, n0, 64 * kb, nullptr, 1.0f, W3 + (size_t)n0 * DM, DM, scr, lane); continue; } r -= I2;
        if (r < I4) { const int nblk = 2 * DFF / 32, kb = r / nblk, nb = r % nblk, n0 = 32 * nb, pn = n0 >> 8, j = n0 & 255;
            const float* src = (j < 128) ? w_g : w_u; const int sc = pn * 128 + (j & 127);
            tr_item(src, DFF, sc, 64 * kb, f_nw, 1.0f, W4 + (size_t)n0 * DM, DM, scr, lane); continue; } r -= I4;
        { const int nblk = DM / 32, kb = r / nblk, nb = r % nblk, n0 = 32 * nb; tr_item(w_d, DM, n0, 64 * kb, nullptr, 1.0f, W5 + (size_t)n0 * DFF, DFF, scr, lane); }
    }
}

template <bool GATES>
__device__ __forceinline__ void phase_norm(const DArgs& A, int l, const float* xsrc, LAS unsigned char* lds, int gw, int NGW, int tid, int lane) {
    bf16* HB = (bf16*)(wsp(A) + WS_HB); float* G = (float*)(wsp(A) + WS_G);
    LAS float* WG = (LAS float*)lds;
    float bias = 0.f;
    if constexpr (GATES) {
        const float* w_in = inp(A, 2) + (size_t)l * DM * N_IN; const float* attn_nw = inp(A, 1) + (size_t)l * DM;
        for (int idx = tid; idx < 16 * DM; idx += NTHREADS) { const int k = idx >> 4, g = idx & 15; WG[g * DM + k] = attn_nw[k] * w_in[(size_t)k * N_IN + SRC_GATE + g]; }
        if (lane < 8) bias = inp(A, 5)[l * NHEAD + lane]; else if (lane < 16) bias = inp(A, 6)[l * NHEAD + lane - 8];
        __syncthreads();
    }
    for (int row = gw; row < MTOK; row += NGW) {
        const GAS f32x4* xr = (const GAS f32x4*)(xsrc + (size_t)row * DM) + lane;
        f32x4 v[8]; float ss = 0.f;
#pragma unroll
        for (int j = 0; j < 8; ++j) { v[j] = xr[64 * j]; ss += (v[j].x * v[j].x + v[j].y * v[j].y) + (v[j].z * v[j].z + v[j].w * v[j].w); }
        const float r = 1.0f / sqrtf(wave_sum(ss) * (1.0f / DM) + EPS);
        GAS unsigned long long* o8 = (GAS unsigned long long*)(HB + (size_t)row * DM) + lane;
#pragma unroll
        for (int j = 0; j < 8; ++j) o8[64 * j] = (unsigned long long)pk2(v[j].x * r, v[j].y * r) | ((unsigned long long)pk2(v[j].z * r, v[j].w * r) << 32);
        if constexpr (GATES) {
            float mine = 0.f;
#pragma unroll 1
            for (int g = 0; g < 16; ++g) { const LAS f32x4* wg = (const LAS f32x4*)(WG + g * DM) + lane; float a = 0.f;
#pragma unroll
                for (int j = 0; j < 8; ++j) { const f32x4 w = wg[64 * j]; a += (v[j].x * w.x + v[j].y * w.y) + (v[j].z * w.z + v[j].w * w.w); }
                a = wave_sum(a); if (lane == g) mine = a; }
            if (lane < 16) { float pre = mine * r + bias; float o;
                if (lane < 8) o = pre; else o = fminf(pre, 0.f) - log1pf(__expf(-fabsf(pre)));
                G[(size_t)row * 16 + lane] = o; }
        }
    }
}

__device__ __forceinline__ void phase_conv(const DArgs& A, int l, int gtid, int NGT) {
    const bf16* P = (const bf16*)(wsp(A) + WS_P); bf16* QKC = (bf16*)(wsp(A) + WS_QKC);
    const float* cw = inp(A, 3) + (size_t)l * 4 * DM; const float* cb = inp(A, 4) + (size_t)l * DM;
    for (int idx = gtid; idx < MTOK * (DM / 8); idx += NGT) {
        const int row = idx >> 8, c = (idx & 255) * 8, t = row & (SEQ - 1);
        float acc[8];
#pragma unroll
        for (int i = 0; i < 8; ++i) acc[i] = cb[c + i];
#pragma unroll
        for (int j = 0; j < 4; ++j) { const int tt = t - 3 + j;
            if (tt >= 0) { const v4u u = *(const GAS v4u*)(P + (size_t)(row - 3 + j) * NP + c); const unsigned uw[4] = {u.x, u.y, u.z, u.w};
#pragma unroll
                for (int k = 0; k < 4; ++k) { acc[2 * k] += cw[j * DM + c + 2 * k] * wlo(uw[k]); acc[2 * k + 1] += cw[j * DM + c + 2 * k + 1] * whi(uw[k]); } } }
        const float sc = (c >= 1024) ? 0.08838834764831845f : 1.0f;
#pragma unroll
        for (int i = 0; i < 8; ++i) acc[i] = acc[i] * sigm(acc[i]) * sc;
        v4u o; o.x = pk2(acc[0], acc[1]); o.y = pk2(acc[2], acc[3]); o.z = pk2(acc[4], acc[5]); o.w = pk2(acc[6], acc[7]);
        *(GAS v4u*)(QKC + (size_t)row * DM + c) = o;
    }
}

struct MlIn { unsigned qw, kw; float v, ig, lf; };
__device__ __forceinline__ MlIn ml_load(const bf16* QKC, const bf16* P, const float* G, size_t row, int h, int dv0, int lane) {
    MlIn r;
    r.qw = ((const GAS unsigned*)(QKC + row * DM + h * 128))[lane];
    r.kw = ((const GAS unsigned*)(QKC + row * DM + 1024 + h * 128))[lane];
    r.v = bfbits2f(P[row * NP + C_MV + h * 256 + dv0 + lane]);
    r.ig = G[row * 16 + h]; r.lf = G[row * 16 + 8 + h];
    return r;
}
__device__ __forceinline__ void phase_mlstm(const DArgs& A, int unit, int lane, LAS float* sm) {
    const bf16* P = (const bf16*)(wsp(A) + WS_P); const bf16* QKC = (const bf16*)(wsp(A) + WS_QKC); const float* G = (const float*)(wsp(A) + WS_G); float* HMF = (float*)(wsp(A) + WS_HMF);
    const int bh = unit >> 2, dv0 = (unit & 3) * 64, b = bh >> 3, h = bh & 7;
    typedef float f32x2v __attribute__((ext_vector_type(2)));
    LAS float* vb = sm + 1024; LAS float* gb = sm + 1280;
    float C[128];
#pragma unroll
    for (int j = 0; j < 128; ++j) C[j] = 0.f;
    float n0 = 0.f, n1 = 0.f, m = 0.f;
    const size_t rowb = (size_t)b * SEQ;
    MlIn pend[4];
#pragma unroll
    for (int s = 0; s < 4; ++s) pend[s] = ml_load(QKC, P, G, rowb + s, h, dv0, lane);
#pragma unroll 1
    for (int t0 = 0; t0 < SEQ; t0 += 4) {
#pragma unroll
        for (int s = 0; s < 4; ++s) {
            *(LAS f32x2v*)(sm + s * 256 + 2 * lane) = (f32x2v){wlo(pend[s].qw), whi(pend[s].qw)};
            *(LAS f32x2v*)(sm + s * 256 + 128 + 2 * lane) = (f32x2v){wlo(pend[s].kw), whi(pend[s].kw)};
            vb[s * 64 + lane] = pend[s].v;
            if (lane == 0) { gb[2 * s] = pend[s].ig; gb[2 * s + 1] = pend[s].lf; }
        }
        const int tn = (t0 + 4 < SEQ) ? t0 + 4 : t0;
#pragma unroll
        for (int s = 0; s < 4; ++s) pend[s] = ml_load(QKC, P, G, rowb + tn + s, h, dv0, lane);
        LDS_WAIT(); asm volatile("" ::: "memory");
#pragma unroll 1
        for (int s = 0; s < 4; ++s) {
            const float ig = gb[2 * s], lf = gb[2 * s + 1], vv = vb[s * 64 + lane];
            const f32x2v qo = *(const LAS f32x2v*)(sm + s * 256 + 2 * lane), ko = *(const LAS f32x2v*)(sm + s * 256 + 128 + 2 * lane);
            const float mn = fmaxf(lf + m, ig); const float fd = __expf(lf + m - mn), id = __expf(ig - mn); m = mn;
            n0 = fd * n0 + id * ko.x; n1 = fd * n1 + id * ko.y;
            const float nq = wave_sum(n0 * qo.x + n1 * qo.y);
            const float iv = id * vv; float d0 = 0.f, d1 = 0.f;
            const LAS f32x4* qp = (const LAS f32x4*)(sm + s * 256); const LAS f32x4* kp = (const LAS f32x4*)(sm + s * 256 + 128);
#pragma unroll
            for (int j = 0; j < 32; ++j) {
                const f32x4 k4 = kp[j], q4 = qp[j];
                C[4 * j] = fd * C[4 * j] + iv * k4.x; C[4 * j + 1] = fd * C[4 * j + 1] + iv * k4.y; C[4 * j + 2] = fd * C[4 * j + 2] + iv * k4.z; C[4 * j + 3] = fd * C[4 * j + 3] + iv * k4.w;
                d0 += C[4 * j] * q4.x + C[4 * j + 2] * q4.z; d1 += C[4 * j + 1] * q4.y + C[4 * j + 3] * q4.w;
            }
            const float hv = (d0 + d1) / fmaxf(fabsf(nq), __expf(-m));
            HMF[(rowb + t0 + s) * DM + h * 256 + dv0 + lane] = hv;
        }
        asm volatile("" ::: "memory");
    }
}

typedef attn::BlockRef<attn::bf16, float> ABlock;
__device__ __forceinline__ ABlock attn_ref(const DArgs& A, int L, int pass) {
    const int vh = L >> 3, x = L & 7, comp = vh & 1, half = (vh >> 1) & 1, h = (vh >> 2) & 7, b = vh >> 5;
    const int qb = pass ? 15 - x : x;
    const attn::bf16* P = (const attn::bf16*)(wsp(A) + WS_P);
    float* O = (float*)(wsp(A) + (comp ? WS_HD2 : WS_HD1));
    ABlock r;
    const size_t row0 = (size_t)b * SEQ;
    r.Q = P + (row0 + (size_t)qb * 256) * NP + C_DQ + h * 256 + comp * 128;
    r.K = P + row0 * NP + C_DK + h * 256 + comp * 128;
    r.V = P + row0 * NP + C_DV + h * 256 + half * 128;
    r.O = O + (row0 + (size_t)qb * 256) * DM + h * 256 + half * 128;
    r.P0 = qb * 256;
    return r;
}
__device__ __forceinline__ void phase_attn(const DArgs& A, char* lds, int a, int GA) {
    constexpr int TOTAL = NBATCH * NHEAD * 4 * 8;
    int L = a; if (L >= TOTAL) return;
    int pass = 0;
    ABlock cur = attn_ref(A, L, 0);
    attn::Seam<attn::bf16> S;
    attn::causal_swa_prime<attn::bf16, float>(cur, SEQ, lds, S);
    for (;;) {
        const bool more_pass = pass == 0, more_item = L + GA < TOTAL, last = !more_pass && !more_item;
        int passn = pass + 1, Ln = L;
        if (!more_pass) { passn = 0; Ln = more_item ? L + GA : L; }
        const ABlock nxt = last ? cur : attn_ref(A, Ln, passn);
        attn::causal_swa_block<attn::bf16, float>(cur, nxt, SEQ, SEQ, lds, S);
        if (last) break;
        cur = nxt; pass = passn; L = Ln;
    }
}

__device__ __forceinline__ void phase_combine(const DArgs& A, int l, int gw, int NGW, int lane) {
    const bf16* P = (const bf16*)(wsp(A) + WS_P); const float* HMF = (const float*)(wsp(A) + WS_HMF); const float* HD1 = (const float*)(wsp(A) + WS_HD1); const float* HD2 = (const float*)(wsp(A) + WS_HD2);
    bf16* HMD = (bf16*)(wsp(A) + WS_HMD);
    const float* lq1 = inp(A, 8) + l * 128; const float* lk1 = inp(A, 9) + l * 128; const float* lq2 = inp(A, 10) + l * 128; const float* lk2 = inp(A, 11) + l * 128;
    const float s1 = wave_sum(lq1[lane] * lk1[lane] + lq1[lane + 64] * lk1[lane + 64]), s2 = wave_sum(lq2[lane] * lk2[lane] + lq2[lane + 64] * lk2[lane + 64]);
    const float lam = expf(s1) - expf(s2) + lam_init_of(l);
    for (int row = gw; row < MTOK; row += NGW) {
#pragma unroll 2
        for (int j = 0; j < 8; ++j) {
            const size_t o = (size_t)row * DM + 256 * j + 4 * lane;
            const f32x4 a = *(const GAS f32x4*)(HMF + o);
            const f32x4 d1 = *(const GAS f32x4*)(HD1 + o), d2 = *(const GAS f32x4*)(HD2 + o);
            const unsigned long long mo = *(const GAS unsigned long long*)(P + (size_t)row * NP + C_MO + 256 * j + 4 * lane);
            const float ssa = wave_sum((a.x * a.x + a.y * a.y) + (a.z * a.z + a.w * a.w));
            const float ra = 1.0f / sqrtf(ssa * (1.0f / 256.0f) + EPS);
            const unsigned m0 = (unsigned)mo, m1 = (unsigned)(mo >> 32);
            const float h0 = a.x * ra * sigm(wlo(m0)), h1 = a.y * ra * sigm(whi(m0)), h2 = a.z * ra * sigm(wlo(m1)), h3 = a.w * ra * sigm(whi(m1));
            *(GAS unsigned long long*)(HMD + (size_t)row * (2 * DM) + 256 * j + 4 * lane) = (unsigned long long)pk2(h0, h1) | ((unsigned long long)pk2(h2, h3) << 32);
            const f32x4 d = d1 - d2 * lam;
            const float ssd = wave_sum((d.x * d.x + d.y * d.y) + (d.z * d.z + d.w * d.w));
            const float rd = 1.0f / sqrtf(ssd * (1.0f / 256.0f) + EPS);
            *(GAS unsigned long long*)(HMD + (size_t)row * (2 * DM) + DM + 256 * j + 4 * lane) = (unsigned long long)pk2(d.x * rd, d.y * rd) | ((unsigned long long)pk2(d.z * rd, d.w * rd) << 32);
        }
    }
}

__device__ __forceinline__ void phase_final(const DArgs& A, int gw, int NGW, int lane) {
    const float* X = (const float*)(wsp(A) + WS_X); const float* fw = inp(A, 20);
    f32x4 w[8];
#pragma unroll
    for (int j = 0; j < 8; ++j) w[j] = ((const GAS f32x4*)fw)[lane + 64 * j];
    for (int row = gw; row < MTOK; row += NGW) {
        const GAS f32x4* xr = (const GAS f32x4*)(X + (size_t)row * DM) + lane;
        f32x4 v[8]; float ss = 0.f;
#pragma unroll
        for (int j = 0; j < 8; ++j) { v[j] = xr[64 * j]; ss += (v[j].x * v[j].x + v[j].y * v[j].y) + (v[j].z * v[j].z + v[j].w * v[j].w); }
        const float r = 1.0f / sqrtf(wave_sum(ss) * (1.0f / DM) + EPS);
        GAS f32x4* o = (GAS f32x4*)(outp(A) + (size_t)row * DM) + lane;
#pragma unroll
        for (int j = 0; j < 8; ++j) o[64 * j] = v[j] * r * w[j];
    }
}

__global__ void __launch_bounds__(NTHREADS, 2) hybrid_fwd(Args KA) {
    extern __shared__ __attribute__((aligned(16))) unsigned char lds[];
    LAS unsigned char* L = (LAS unsigned char*)lds;
    DArgs A; A.L = L; A.l_lo = KA.l_lo; A.l_hi = KA.l_hi; A.ph_lo = KA.ph_lo; A.ph_hi = KA.ph_hi; A.do_final = KA.do_final; A.use_bar = KA.use_bar;
    volatile LAS unsigned* MISC = (volatile LAS unsigned*)(L + MISC_OFF);
#define tid (T_)
#define lane (T_ & 63)
#define wave (__builtin_amdgcn_readfirstlane(T_ >> 6))
#define G (GX_)
#define bx (BX_)
#define gw (bx * NWAVES + wave)
#define NGW (G * NWAVES)
#define gtid (bx * NTHREADS + tid)
#define NGT (G * NTHREADS)
    const int T_ = tidx(), BX_ = sopq((int)blockIdx.x), GX_ = sopq((int)gridDim.x);
    gu32* ctl = (gu32*)(KA.ws + WS_CTL);
    for (int u = tid; u < (LDS_BYTES - LDSCTL_OFF) / 4; u += NTHREADS) ((LAS unsigned*)(L + LDSCTL_OFF))[u] = 0u;
    __syncthreads();
    if (tid == 0) {
#pragma unroll
        for (int i = 0; i < 21; ++i) ((LAS unsigned long long*)(L + PTR_OFF))[i] = (unsigned long long)KA.in[i];
    }
    if (tid == 21) ((LAS unsigned long long*)(L + PTR_OFF))[21] = (unsigned long long)KA.out;
    if (tid == 22) ((LAS unsigned long long*)(L + PTR_OFF))[22] = (unsigned long long)KA.ws;
    __syncthreads();
    XcdBarrier bar; bar.bar = (unsigned*)(ctl + CW_BAR); bar.x = 0; bar.st = nullptr;
    if (A.use_bar) bar = xcd_barrier_post((unsigned*)(ctl + CW_BAR), MISC + 8);
#define IN(k) (A.ph_lo <= (k) && (k) < A.ph_hi)
#define SEAM() do { if (A.use_bar) xcd_barrier(bar); else __syncthreads(); } while (0)
#define WSB(off) ((bf16*)(wsp(A) + (off)))
#define WSF(off) ((float*)(wsp(A) + (off)))
#pragma unroll 1
    for (int l = A.l_lo; l < A.l_hi; ++l) {
        if (IN(0)) { const int T_ = tidx(), BX_ = sopq((int)blockIdx.x), GX_ = sopq((int)gridDim.x);
            phase_weights(A, l, L, gw, NGW, wave, lane);
            __syncthreads();
            phase_norm<true>(A, l, (l == 0) ? inp(A, 0) : (const float*)WSF(WS_X), L, gw, NGW, tid, lane);
            SEAM();
        }
        if (IN(1)) { const int T_ = tidx(), BX_ = sopq((int)blockIdx.x), GX_ = sopq((int)gridDim.x);
            pg8::Gemm g{WSB(WS_HB), WSB(WS_W1), MTOK, NP, DM, DM}; pg8::StaticOrder S; S.init(MTOK, NP, G, bx);
            pg8::EpiStoreBf16 E{WSB(WS_P), NP};
            pg8::gemm_phase<pg8::EpiStoreBf16, pg8::StaticOrder, true, true>(L, g, S, E);
            SEAM();
        }
        if (IN(2)) { const int T_ = tidx(), BX_ = sopq((int)blockIdx.x), GX_ = sopq((int)gridDim.x); phase_conv(A, l, gtid, NGT); SEAM(); }
        if (IN(3)) { const int T_ = tidx(), BX_ = sopq((int)blockIdx.x), GX_ = sopq((int)gridDim.x);
            if (bx < MLSTM_WGS) { if (wave < 4) phase_mlstm(A, bx * 4 + wave, lane, (LAS float*)(L + wave * 8192)); }
            else phase_attn(A, (char*)lds, bx - MLSTM_WGS, G - MLSTM_WGS);
            SEAM();
        }
        if (IN(4)) { const int T_ = tidx(), BX_ = sopq((int)blockIdx.x), GX_ = sopq((int)gridDim.x); phase_combine(A, l, gw, NGW, lane); SEAM(); }
        if (IN(5)) { const int T_ = tidx(), BX_ = sopq((int)blockIdx.x), GX_ = sopq((int)gridDim.x);
            pg8::Gemm g{WSB(WS_HMD), WSB(WS_W2), MTOK, DM, DM, 2 * DM}; pg8::HalfKOrder S; S.init(MTOK, DM, G, bx);
            pg8::EpiGated E{WSB(WS_P), NP, C_GM, C_GD, WSB(WS_Y), DM};
            pg8::gemm_phase<pg8::EpiGated, pg8::HalfKOrder, true, true>(L, g, S, E);
            SEAM();
        }
        if (IN(6)) { const int T_ = tidx(), BX_ = sopq((int)blockIdx.x), GX_ = sopq((int)gridDim.x);
            pg8::Gemm g{WSB(WS_Y), WSB(WS_W3), MTOK, DM, DM, DM}; pg8::StaticOrder S; S.init(MTOK, DM, G, bx);
            pg8::EpiResid E{(l == 0) ? inp(A, 0) : (const float*)WSF(WS_X), WSF(WS_X), DM};
            pg8::gemm_phase<pg8::EpiResid, pg8::StaticOrder, true, true>(L, g, S, E);
            SEAM();
        }
        if (IN(7)) { const int T_ = tidx(), BX_ = sopq((int)blockIdx.x), GX_ = sopq((int)gridDim.x); phase_norm<false>(A, l, WSF(WS_X), L, gw, NGW, tid, lane); SEAM(); }
        if (IN(8)) { const int T_ = tidx(), BX_ = sopq((int)blockIdx.x), GX_ = sopq((int)gridDim.x);
            pg8::Gemm g{WSB(WS_HB), WSB(WS_W4), MTOK, 2 * DFF, DM, DM}; pg8::StaticOrder S; S.init(MTOK, 2 * DFF, G, bx);
            pg8::EpiSwiglu E{WSB(WS_P), DFF};
            pg8::gemm_phase<pg8::EpiSwiglu, pg8::StaticOrder, true, true>(L, g, S, E);
            SEAM();
        }
        if (IN(9)) { const int T_ = tidx(), BX_ = sopq((int)blockIdx.x), GX_ = sopq((int)gridDim.x);
            pg8::Gemm g{WSB(WS_P), WSB(WS_W5), MTOK, DM, DFF, DFF}; pg8::StaticOrder S; S.init(MTOK, DM, G, bx);
            pg8::EpiResid E{WSF(WS_X), WSF(WS_X), DM};
            pg8::gemm_phase<pg8::EpiResid, pg8::StaticOrder, true, true>(L, g, S, E);
            SEAM();
        }
    }
    if (A.do_final) { const int T_ = tidx(), BX_ = sopq((int)blockIdx.x), GX_ = sopq((int)gridDim.x); phase_final(A, gw, NGW, lane); }
#undef IN
#undef SEAM
#undef WSB
#undef WSF
#undef tid
#undef lane
#undef wave
#undef G
#undef bx
#undef gw
#undef NGW
#undef gtid
#undef NGT
}

#ifndef MK_ONE_LAUNCH
#define MK_ONE_LAUNCH 1
#endif
extern "C" void kernel_launch(void* const* d_in, const int* in_sizes, int n_in, void* d_out, int out_size, void* d_ws, size_t ws_size, hipStream_t stream) {
    static int grid = 0;
    if (grid == 0) {
        if (n_in != 21 || in_sizes[0] != MTOK * DM || out_size != MTOK * DM || ws_size < WS_END) {
            fprintf(stderr, "kernel_launch: shape mismatch (n_in %d, in0 %d, out %d, ws %zu); nothing launched\n", n_in, n_in > 0 ? in_sizes[0] : -1, out_size, ws_size); grid = -1; return; }
        int dev = 0, cus = 0, per_cu = 0;
        if (hipGetDevice(&dev) != hipSuccess || hipDeviceGetAttribute(&cus, hipDeviceAttributeMultiprocessorCount, dev) != hipSuccess) { grid = -1; return; }
        if (hipFuncSetAttribute((const void*)hybrid_fwd, hipFuncAttributeMaxDynamicSharedMemorySize, LDS_BYTES) != hipSuccess) { fprintf(stderr, "kernel_launch: hipFuncSetAttribute failed\n"); grid = -1; return; }
        if (hipOccupancyMaxActiveBlocksPerMultiprocessor(&per_cu, (const void*)hybrid_fwd, NTHREADS, LDS_BYTES) != hipSuccess || per_cu < 1)
            fprintf(stderr, "kernel_launch: note: occupancy query reports %d workgroups per CU\n", per_cu);
        (void)hipGetLastError();
        grid = cus;
    }
    if (grid < 0) return;
    if (hipMemsetAsync((char*)d_ws + WS_CTL, 0, CTL_ZERO_BYTES, stream) != hipSuccess) { fprintf(stderr, "kernel_launch: memset failed\n"); return; }
    Args a{};
    for (int i = 0; i < 21; ++i) a.in[i] = (const float*)d_in[i];
    a.out = (float*)d_out; a.ws = (unsigned char*)d_ws;
#if MK_ONE_LAUNCH
    a.l_lo = 0; a.l_hi = DEPTH; a.ph_lo = 0; a.ph_hi = 10; a.do_final = 1; a.use_bar = 1;
    hipLaunchKernelGGL(hybrid_fwd, dim3(grid), dim3(NTHREADS), LDS_BYTES, stream, a);
#else
    for (int l = 0; l < DEPTH; ++l)
        for (int ph = 0; ph < 10; ++ph) {
            a.l_lo = l; a.l_hi = l + 1; a.ph_lo = ph; a.ph_hi = ph + 1; a.do_final = 0; a.use_bar = 0;
            hipLaunchKernelGGL(hybrid_fwd, dim3(grid), dim3(NTHREADS), LDS_BYTES, stream, a);
        }
    a.l_lo = 0; a.l_hi = 0; a.ph_lo = 0; a.ph_hi = 0; a.do_final = 1; a.use_bar = 0;
    hipLaunchKernelGGL(hybrid_fwd, dim3(grid), dim3(NTHREADS), LDS_BYTES, stream, a);
#endif
    const hipError_t le = hipPeekAtLastError();
    if (le != hipSuccess) fprintf(stderr, "kernel_launch: launch failed: %s\n", hipGetErrorName(le));
}
```

```cpp
#include <hip/hip_runtime.h>
#include <hip/hip_bf16.h>
#include <cstdio>
#include <cstdint>
__device__ __forceinline__ int tidx() { int t = (int)threadIdx.x; asm volatile("" : "+v"(t)); return t; }
__device__ __forceinline__ int sopq(int v) { asm volatile("" : "+s"(v)); return v; }
namespace pg8 {
#define PG8_LAS __attribute__((address_space(3)))
typedef unsigned short bf16_t;
typedef short bf16x8 __attribute__((ext_vector_type(8)));
typedef float f32x4 __attribute__((ext_vector_type(4)));
typedef unsigned u32x4 __attribute__((ext_vector_type(4)));
constexpr int BM = 256, BK = 64, HALF = 128, HTB = HALF * BK * 2  , STAGE_BYTES = 8 * HTB, NXCD = 8, WGM = 8;

__host__ __device__ __forceinline__ int lds_byte(int r, int c) { const int st = (r >> 4) * 2 + (c >> 5), rr = r & 15, cc = c & 31, ob = rr * 64 + cc * 2; return st * 1024 + (ob ^ (((ob >> 9) & 1) << 5)); }
__host__ __device__ __forceinline__ void stage_rc(int b, int& R, int& C) { const int st = b / 1024, sb = b % 1024, swz = sb ^ (((sb >> 9) & 1) << 5); R = (st >> 1) * 16 + swz / 64; C = (st & 1) * 32 + (swz % 64) / 2; }
__host__ __device__ __forceinline__ int perm32(int rho) { const int n = rho >> 4, i = rho & 15; return 8 * (i >> 2) + 4 * n + (i & 3); }

struct Unit { int pm, pn, kh; };
struct Gemm { const bf16_t* A; const bf16_t* Bt; int M, N, K, ld; };

struct StaticOrder {
    int nM, nN, nwg, G, c;
    __host__ __device__ void init(int M, int N, int G_, int c_) { nM = M / BM; nN = N / BM; nwg = nM * nN; G = G_; c = c_; }
    __host__ __device__ bool next(int i, Unit& u) const {
        const long L = (long)i * G + c; if (L >= nwg) return false;
        int wgid = (int)L; { const int q = nwg / NXCD, r = nwg % NXCD, xcd = wgid % NXCD, off = wgid / NXCD; wgid = (xcd < r ? xcd * (q + 1) : r * (q + 1) + (xcd - r) * q) + off; }
        const int nig = WGM * nN, gid = wgid / nig, fm = gid * WGM, gsz = (nM - fm) < WGM ? (nM - fm) : WGM;
        u.pm = fm + ((wgid % nig) % gsz); u.pn = (wgid % nig) / gsz; u.kh = 0; return true;
    }
    __device__ __forceinline__ void a_ready(const Unit&) const {}
    __device__ __forceinline__ void done(const Unit&) const {}
};
struct HalfKOrder : StaticOrder {
    __host__ __device__ bool next(int i, Unit& u) const { const bool ok = StaticOrder::next(i >> 1, u); u.kh = i & 1; return ok; }
};

__device__ __forceinline__ unsigned cvt_pk_bf16(float lo, float hi) { unsigned r; asm volatile("v_cvt_pk_bf16_f32 %0, %1, %2" : "=v"(r) : "v"(lo), "v"(hi)); return r; }
typedef float f32x2 __attribute__((ext_vector_type(2)));
typedef unsigned u32x2 __attribute__((ext_vector_type(2)));
__device__ __forceinline__ float bf_lo(unsigned w) { return __uint_as_float(w << 16); }
__device__ __forceinline__ float bf_hi(unsigned w) { return __uint_as_float(w & 0xffff0000u); }
__device__ __forceinline__ float sigmoidf_(float x) { return __builtin_amdgcn_rcpf(1.0f + __expf(-x)); }

struct EpiStoreBf16 {
    static constexpr bool PERM = true, AFTER_DRAIN = false, MID = false;
    bf16_t* O; int ldc;
    __device__ __forceinline__ void operator()(f32x4 (&acc)[2][2][4][2], const Unit& u, int wr, int wc, int fr, int fq) const {
        const int row0 = u.pm * BM + wr * 64 + fr, col0 = u.pn * BM + wc * 32 + 8 * fq;
#pragma unroll
        for (int ai = 0; ai < 2; ++ai)
#pragma unroll
            for (int m = 0; m < 4; ++m) { bf16_t* rowp = O + (size_t)(row0 + ai * HALF + m * 16) * ldc + col0;
#pragma unroll
                for (int bj = 0; bj < 2; ++bj) { const f32x4 v0 = acc[ai][bj][m][0], v1 = acc[ai][bj][m][1];
                    u32x4 w; w.x = cvt_pk_bf16(v0[0], v0[1]); w.y = cvt_pk_bf16(v0[2], v0[3]); w.z = cvt_pk_bf16(v1[0], v1[1]); w.w = cvt_pk_bf16(v1[2], v1[3]);
                    *(u32x4*)(rowp + bj * HALF) = w; } }
    }
};
constexpr int NSSQ = 32;
__device__ __forceinline__ float xrow16_sum(float x) {
    auto s = __builtin_amdgcn_permlane16_swap(__float_as_uint(x), __float_as_uint(x), false, false);
    x = __uint_as_float(s[0]) + __uint_as_float(s[1]);
    auto t = __builtin_amdgcn_permlane32_swap(__float_as_uint(x), __float_as_uint(x), false, false);
    return __uint_as_float(t[0]) + __uint_as_float(t[1]);
}
__device__ __forceinline__ void load_rscale(const float* ssq, PG8_LAS float* rt, const Unit& u, int wr, int fr, int fq, float (&r)[2][4]) {
    const int lane = fr + 16 * fq;
#pragma unroll
    for (int ai = 0; ai < 2; ++ai) { const f32x4* p = (const f32x4*)(ssq + (size_t)(u.pm * BM + ai * HALF + wr * 64 + lane) * NSSQ); f32x4 t = p[0];
#pragma unroll
        for (int j = 1; j < 8; ++j) t += p[j];
        rt[ai * 64 + lane] = __builtin_amdgcn_rsqf(((t[0] + t[1]) + (t[2] + t[3])) * (1.0f / 2048.0f) + 1e-6f); }
    asm volatile("s_waitcnt lgkmcnt(0)" ::: "memory");
#pragma unroll
    for (int ai = 0; ai < 2; ++ai)
#pragma unroll
        for (int m = 0; m < 4; ++m) r[ai][m] = rt[ai * 64 + m * 16 + fr];
    asm volatile("" ::: "memory");
}
__device__ __forceinline__ void get_rscale(const float* ssq, PG8_LAS float* rtb, int pm0, const Unit& u, int wr, int wc, int fr, int fq, float (&r)[2][4]) {
    if (u.pm == pm0) {
#pragma unroll
        for (int ai = 0; ai < 2; ++ai)
#pragma unroll
            for (int m = 0; m < 4; ++m) r[ai][m] = rtb[ai * HALF + wr * 64 + m * 16 + fr];
    } else load_rscale(ssq, rtb + 256 + (wr * 4 + wc) * 128, u, wr, fr, fq, r);
}
struct EpiStoreBf16R {
    static constexpr bool PERM = true, AFTER_DRAIN = false, MID = false;
    bf16_t* O; int ldc; const float* ssq; PG8_LAS float* rtb; int pm0; int sg_lo, sg_hi;
    __device__ __forceinline__ void operator()(f32x4 (&acc)[2][2][4][2], const Unit& u, int wr, int wc, int fr, int fq) const {
        float r[2][4]; get_rscale(ssq, rtb, pm0, u, wr, wc, fr, fq, r);
        const int row0 = u.pm * BM + wr * 64 + fr, col0 = u.pn * BM + wc * 32 + 8 * fq;
        const bool sg = (u.pn >= sg_lo) && (u.pn < sg_hi);
#pragma unroll
        for (int ai = 0; ai < 2; ++ai)
#pragma unroll
            for (int m = 0; m < 4; ++m) { bf16_t* rowp = O + (size_t)(row0 + ai * HALF + m * 16) * ldc + col0; const float rr = r[ai][m];
#pragma unroll
                for (int bj = 0; bj < 2; ++bj) { f32x4 v0 = acc[ai][bj][m][0] * rr, v1 = acc[ai][bj][m][1] * rr;
                    if (sg) {
#pragma unroll
                        for (int e = 0; e < 4; ++e) { v0[e] = __builtin_amdgcn_rcpf(1.0f + __expf(-v0[e])); v1[e] = __builtin_amdgcn_rcpf(1.0f + __expf(-v1[e])); } }
                    u32x4 w; w.x = cvt_pk_bf16(v0[0], v0[1]); w.y = cvt_pk_bf16(v0[2], v0[3]); w.z = cvt_pk_bf16(v1[0], v1[1]); w.w = cvt_pk_bf16(v1[2], v1[3]);
                    *(u32x4*)(rowp + bj * HALF) = w; } }
    }
};
struct EpiResidStats {
    static constexpr bool PERM = false, AFTER_DRAIN = false, MID = false;
    const float* xin; float* xout; bf16_t* xb; float* ssq; int ldc;
    __device__ __forceinline__ void operator()(f32x4 (&acc)[2][2][4][2], const Unit& u, int wr, int wc, int fr, int fq) const {
        const int row0 = u.pm * BM + wr * 64 + fr, col0 = u.pn * BM + wc * 32 + 4 * fq;
#pragma unroll
        for (int ai = 0; ai < 2; ++ai)
#pragma unroll
            for (int m = 0; m < 4; ++m) { const int row = row0 + ai * HALF + m * 16; const size_t off = (size_t)row * ldc + col0; float sq = 0.f;
#pragma unroll
                for (int bj = 0; bj < 2; ++bj)
#pragma unroll
                    for (int n = 0; n < 2; ++n) { const size_t o2 = off + bj * HALF + n * 16; const f32x4 xv = *(const f32x4*)(xin + o2) + acc[ai][bj][m][n]; *(f32x4*)(xout + o2) = xv;
                        sq += (xv[0] * xv[0] + xv[1] * xv[1]) + (xv[2] * xv[2] + xv[3] * xv[3]);
                        u32x2 w; w.x = cvt_pk_bf16(xv[0], xv[1]); w.y = cvt_pk_bf16(xv[2], xv[3]); *(u32x2*)(xb + o2) = w; }
                sq = xrow16_sum(sq);
                if (fq == 0) ssq[(size_t)row * NSSQ + u.pn * 4 + wc] = sq; }
    }
};
struct EpiResidB {
    static constexpr bool PERM = true, AFTER_DRAIN = false, MID = false;
    bf16_t* xb; float* ssq; float* xf; int ldc;
    __device__ __forceinline__ void operator()(f32x4 (&acc)[2][2][4][2], const Unit& u, int wr, int wc, int fr, int fq) const {
        const int row0 = u.pm * BM + wr * 64 + fr, col0 = u.pn * BM + wc * 32 + 8 * fq;
#pragma unroll
        for (int ai = 0; ai < 2; ++ai)
#pragma unroll
            for (int m = 0; m < 4; ++m) { const int row = row0 + ai * HALF + m * 16; const size_t off = (size_t)row * ldc + col0; float sq = 0.f;
#pragma unroll
                for (int bj = 0; bj < 2; ++bj) { const u32x4 xi = *(const u32x4*)(xb + off + bj * HALF);
                    f32x4 v0 = acc[ai][bj][m][0], v1 = acc[ai][bj][m][1];
                    v0[0] += bf_lo(xi.x); v0[1] += bf_hi(xi.x); v0[2] += bf_lo(xi.y); v0[3] += bf_hi(xi.y); v1[0] += bf_lo(xi.z); v1[1] += bf_hi(xi.z); v1[2] += bf_lo(xi.w); v1[3] += bf_hi(xi.w);
                    sq += ((v0[0] * v0[0] + v0[1] * v0[1]) + (v0[2] * v0[2] + v0[3] * v0[3])) + ((v1[0] * v1[0] + v1[1] * v1[1]) + (v1[2] * v1[2] + v1[3] * v1[3]));
                    u32x4 w; w.x = cvt_pk_bf16(v0[0], v0[1]); w.y = cvt_pk_bf16(v0[2], v0[3]); w.z = cvt_pk_bf16(v1[0], v1[1]); w.w = cvt_pk_bf16(v1[2], v1[3]);
                    *(u32x4*)(xb + off + bj * HALF) = w;
                    if (xf) { *(f32x4*)(xf + off + bj * HALF) = v0; *(f32x4*)(xf + off + bj * HALF + 4) = v1; } }
                sq = xrow16_sum(sq);
                if (fq == 0) ssq[(size_t)row * NSSQ + u.pn * 4 + wc] = sq; }
    }
};
struct EpiResid {
    static constexpr bool PERM = false, AFTER_DRAIN = false, MID = false;
    const float* xin; float* xout; int ldc;
    __device__ __forceinline__ void operator()(f32x4 (&acc)[2][2][4][2], const Unit& u, int wr, int wc, int fr, int fq) const {
        const int row0 = u.pm * BM + wr * 64 + fr, col0 = u.pn * BM + wc * 32 + 4 * fq;
#pragma unroll
        for (int ai = 0; ai < 2; ++ai)
#pragma unroll
            for (int m = 0; m < 4; ++m) { const size_t off = (size_t)(row0 + ai * HALF + m * 16) * ldc + col0;
#pragma unroll
                for (int bj = 0; bj < 2; ++bj)
#pragma unroll
                    for (int n = 0; n < 2; ++n) { const size_t o2 = off + bj * HALF + n * 16; const f32x4 xv = *(const f32x4*)(xin + o2); *(f32x4*)(xout + o2) = xv + acc[ai][bj][m][n]; } }
    }
};
struct EpiSwiglu {
    static constexpr bool PERM = true, AFTER_DRAIN = false, MID = false;
    bf16_t* O; int ldc;
    __device__ __forceinline__ void operator()(f32x4 (&acc)[2][2][4][2], const Unit& u, int wr, int wc, int fr, int fq) const {
        const int row0 = u.pm * BM + wr * 64 + fr, col0 = u.pn * HALF + wc * 32 + 8 * fq;
#pragma unroll
        for (int ai = 0; ai < 2; ++ai)
#pragma unroll
            for (int m = 0; m < 4; ++m) { bf16_t* rowp = O + (size_t)(row0 + ai * HALF + m * 16) * ldc + col0;
                float r[8];
#pragma unroll
                for (int n = 0; n < 2; ++n)
#pragma unroll
                    for (int i = 0; i < 4; ++i) { const float g = acc[ai][0][m][n][i], up = acc[ai][1][m][n][i]; r[n * 4 + i] = g * sigmoidf_(g) * up; }
                u32x4 w; w.x = cvt_pk_bf16(r[0], r[1]); w.y = cvt_pk_bf16(r[2], r[3]); w.z = cvt_pk_bf16(r[4], r[5]); w.w = cvt_pk_bf16(r[6], r[7]);
                *(u32x4*)rowp = w; }
    }
};
struct EpiSwigluR {
    static constexpr bool PERM = true, AFTER_DRAIN = false, MID = false;
    bf16_t* O; int ldc; const float* ssq; PG8_LAS float* rtb; int pm0;
    __device__ __forceinline__ void operator()(f32x4 (&acc)[2][2][4][2], const Unit& u, int wr, int wc, int fr, int fq) const {
        float r[2][4]; get_rscale(ssq, rtb, pm0, u, wr, wc, fr, fq, r);
        const int row0 = u.pm * BM + wr * 64 + fr, col0 = u.pn * HALF + wc * 32 + 8 * fq;
#pragma unroll
        for (int ai = 0; ai < 2; ++ai)
#pragma unroll
            for (int m = 0; m < 4; ++m) { bf16_t* rowp = O + (size_t)(row0 + ai * HALF + m * 16) * ldc + col0; const float rr = r[ai][m];
                float o[8];
#pragma unroll
                for (int n = 0; n < 2; ++n)
#pragma unroll
                    for (int i = 0; i < 4; ++i) { const float g = acc[ai][0][m][n][i] * rr, up = acc[ai][1][m][n][i] * rr; o[n * 4 + i] = g * sigmoidf_(g) * up; }
                u32x4 w; w.x = cvt_pk_bf16(o[0], o[1]); w.y = cvt_pk_bf16(o[2], o[3]); w.z = cvt_pk_bf16(o[4], o[5]); w.w = cvt_pk_bf16(o[6], o[7]);
                *(u32x4*)rowp = w; }
    }
};
struct EpiGated {
    static constexpr bool PERM = true, AFTER_DRAIN = false, MID = true;
    const bf16_t* P; int ldp, cgm, cgd; bf16_t* O; int ldc;
    __device__ __forceinline__ static float cl(float x) { return fminf(fmaxf(x, -30.f), 30.f); }
    __device__ __forceinline__ void operator()(f32x4 (&acc)[2][2][4][2], const Unit& u, int wr, int wc, int fr, int fq) const { if (u.kh == 0) mid(acc, u, wr, wc, fr, fq); else fin(acc, u, wr, wc, fr, fq); }
    __device__ __forceinline__ void mid(f32x4 (&acc)[2][2][4][2], const Unit& u, int wr, int wc, int fr, int fq) const {
        const int row0 = u.pm * BM + wr * 64 + fr, col0 = u.pn * BM + wc * 32 + 8 * fq;
#pragma unroll
        for (int ai = 0; ai < 2; ++ai)
#pragma unroll
            for (int m = 0; m < 4; ++m) { const bf16_t* rowp = P + (size_t)(row0 + ai * HALF + m * 16) * ldp + col0;
#pragma unroll
                for (int bj = 0; bj < 2; ++bj) { const u32x4 a = *(const u32x4*)(rowp + cgm + bj * HALF), b = *(const u32x4*)(rowp + cgd + bj * HALF);
                    const unsigned aw[4] = {a.x, a.y, a.z, a.w}, bw[4] = {b.x, b.y, b.z, b.w};
#pragma unroll
                    for (int k = 0; k < 4; ++k) { const float gm0 = cl(bf_lo(aw[k])), gm1 = cl(bf_hi(aw[k])), gd0 = cl(bf_lo(bw[k])), gd1 = cl(bf_hi(bw[k]));
                        const float r0 = (1.0f + __expf(-gd0)) * __builtin_amdgcn_rcpf(1.0f + __expf(-gm0)), r1 = (1.0f + __expf(-gd1)) * __builtin_amdgcn_rcpf(1.0f + __expf(-gm1));
                        acc[ai][bj][m][k >> 1][(k & 1) * 2] *= r0; acc[ai][bj][m][k >> 1][(k & 1) * 2 + 1] *= r1; } }
                asm volatile("" ::: "memory"); }
    }
    __device__ __forceinline__ void fin(f32x4 (&acc)[2][2][4][2], const Unit& u, int wr, int wc, int fr, int fq) const {
        const int row0 = u.pm * BM + wr * 64 + fr, col0 = u.pn * BM + wc * 32 + 8 * fq;
#pragma unroll
        for (int ai = 0; ai < 2; ++ai)
#pragma unroll
            for (int m = 0; m < 4; ++m) { const size_t r = (size_t)(row0 + ai * HALF + m * 16); const bf16_t* gp = P + r * ldp + cgd + col0; bf16_t* rowp = O + r * ldc + col0;
#pragma unroll
                for (int bj = 0; bj < 2; ++bj) { const u32x4 b = *(const u32x4*)(gp + bj * HALF); const unsigned bw[4] = {b.x, b.y, b.z, b.w}; float o[8];
#pragma unroll
                    for (int k = 0; k < 4; ++k) { const float s0 = sigmoidf_(cl(bf_lo(bw[k]))), s1 = sigmoidf_(cl(bf_hi(bw[k])));
                        o[2 * k] = acc[ai][bj][m][k >> 1][(k & 1) * 2] * s0; o[2 * k + 1] = acc[ai][bj][m][k >> 1][(k & 1) * 2 + 1] * s1; }
                    u32x4 w; w.x = cvt_pk_bf16(o[0], o[1]); w.y = cvt_pk_bf16(o[2], o[3]); w.z = cvt_pk_bf16(o[4], o[5]); w.w = cvt_pk_bf16(o[6], o[7]);
                    *(u32x4*)(rowp + bj * HALF) = w; }
                asm volatile("" ::: "memory"); }
    }
};

template <class Epi, class Sched, bool ALIGN_EPI = false, bool SP2 = false>
__device__ __forceinline__ void gemm_phase(PG8_LAS unsigned char* lds, const Gemm g, const Sched& S, const Epi& E) {
    const int tid = tidx(), wid = __builtin_amdgcn_readfirstlane(tid >> 6), lane = tid & 63, wr = wid >> 2, wc = wid & 3, fr = lane & 15, fq = lane >> 4;
    const int K = g.K, nt = K / BK, LD = g.ld;
    unsigned voffA[2], voffB[2];
#pragma unroll
    for (int i = 0; i < 2; ++i) { int R, C; stage_rc(tid * 16 + i * 8192, R, C); const int Rb = Epi::PERM ? ((R & ~31) + perm32(R & 31)) : R;
        voffA[i] = (unsigned)(R * LD + C) * 2u; voffB[i] = (unsigned)(Rb * LD + C) * 2u; }
    const size_t kstep = (size_t)(BK * 2);
    const size_t hstep = (size_t)HALF * LD * 2;
    const size_t tstep = 2 * hstep;
    const unsigned ldsw = (unsigned)wid * 1024u;
    const int aoff = lds_byte(wr * 64 + fr, fq * 8), boff = lds_byte(wc * 32 + fr, fq * 8);
#define PG8_SA(b, h) (((b) * 2 + (h)) * HTB)
#define PG8_SB(b, h) ((4 + (b) * 2 + (h)) * HTB)
#define PG8_STAGE(bufoff, gbase, voff) do { _Pragma("unroll") for (int _i = 0; _i < 2; ++_i) \
        __builtin_amdgcn_global_load_lds((const unsigned*)((const char*)(gbase) + (voff)[_i]), (PG8_LAS unsigned*)(lds + (bufoff) + ldsw + _i * 8192), 16, 0, 0); } while (0)
#define PG8_LDA(dst, b, h) do { _Pragma("unroll") for (int m = 0; m < 4; ++m) _Pragma("unroll") for (int k = 0; k < 2; ++k) dst[m][k] = *(const PG8_LAS bf16x8*)(lds + PG8_SA(b, h) + aoff + m * 2048 + k * 1024); } while (0)
#define PG8_LDB(dst, b, h) do { _Pragma("unroll") for (int n = 0; n < 2; ++n) _Pragma("unroll") for (int k = 0; k < 2; ++k) dst[n][k] = *(const PG8_LAS bf16x8*)(lds + PG8_SB(b, h) + boff + n * 2048 + k * 1024); } while (0)
#define PG8_MMA(ai, bj, At, Bt) do { __builtin_amdgcn_s_setprio(1); _Pragma("unroll") for (int m = 0; m < 4; ++m) _Pragma("unroll") for (int n = 0; n < 2; ++n) _Pragma("unroll") for (int k = 0; k < 2; ++k) \
        acc[ai][bj][m][n] = __builtin_amdgcn_mfma_f32_16x16x32_bf16(Bt[n][k], At[m][k], acc[ai][bj][m][n], 0, 0, 0); __builtin_amdgcn_s_setprio(0); } while (0)
#define PG8_WAIT_V(n) asm volatile("s_waitcnt vmcnt(" #n ")" ::: "memory")
#define PG8_WAIT_L(n) asm volatile("s_waitcnt lgkmcnt(" #n ")" ::: "memory")
#define PG8_BAR __builtin_amdgcn_s_barrier()
#define PG8_SCHED __builtin_amdgcn_sched_barrier(0)
    Unit cur, nxt; int ui = 0;
    if (!S.next(0, cur)) return;
    f32x4 acc[2][2][4][2];
#pragma unroll
    for (int a = 0; a < 2; ++a)
#pragma unroll
        for (int b = 0; b < 2; ++b)
#pragma unroll
            for (int m = 0; m < 4; ++m)
#pragma unroll
                for (int n = 0; n < 2; ++n) acc[a][b][m][n] = (f32x4){0.f, 0.f, 0.f, 0.f};
    bf16x8 At[4][2], B0[2][2], B1[2][2];
    const size_t kslice = (size_t)K * 2;
    const char* cA = (const char*)g.A + (size_t)cur.pm * tstep + (size_t)cur.kh * kslice; const char* cB = (const char*)g.Bt + (size_t)cur.pn * tstep + (size_t)cur.kh * kslice;
    S.a_ready(cur);
    if constexpr (SP2) {
        PG8_STAGE(PG8_SB(0, 0), cB, voffB); PG8_STAGE(PG8_SB(0, 1), cB + hstep, voffB); PG8_STAGE(PG8_SA(0, 0), cA, voffA); PG8_STAGE(PG8_SA(0, 1), cA + hstep, voffA);
        if (wr == 1) PG8_BAR;
        PG8_WAIT_V(2); PG8_BAR;
        PG8_STAGE(PG8_SB(1, 0), cB + kstep, voffB); PG8_STAGE(PG8_SA(1, 0), cA + kstep, voffA); PG8_STAGE(PG8_SB(1, 1), cB + hstep + kstep, voffB);
        PG8_WAIT_V(6); PG8_BAR;
    } else {
        PG8_STAGE(PG8_SB(0, 0), cB, voffB); PG8_STAGE(PG8_SA(0, 0), cA, voffA); PG8_STAGE(PG8_SB(0, 1), cB + hstep, voffB); PG8_STAGE(PG8_SA(0, 1), cA + hstep, voffA);
        if (wr == 1) PG8_BAR;
        PG8_WAIT_V(4); PG8_BAR;
        PG8_STAGE(PG8_SB(1, 0), cB + kstep, voffB); PG8_STAGE(PG8_SA(1, 0), cA + kstep, voffA); PG8_STAGE(PG8_SB(1, 1), cB + hstep + kstep, voffB);
        PG8_WAIT_V(6); PG8_BAR;
    }
    for (;;) {
        const bool has_next = S.next(ui + 1, nxt);
        const char* nA = has_next ? (const char*)g.A + (size_t)nxt.pm * tstep + (size_t)nxt.kh * kslice : cA; const char* nB = has_next ? (const char*)g.Bt + (size_t)nxt.pn * tstep + (size_t)nxt.kh * kslice : cB;
        for (int t = 0; t < nt; t += 2) {
            const bool last = (t == nt - 2);
            const char* a1 = cA + (size_t)(t + 1) * kstep;
            const char* a2 = last ? nA : cA + (size_t)(t + 2) * kstep; const char* b2 = last ? nB : cB + (size_t)(t + 2) * kstep;
            const char* a3 = a2 + kstep; const char* b3 = b2 + kstep;
            if (last && has_next) S.a_ready(nxt);
            if constexpr (SP2) {
            PG8_LDB(B0, 0, 0); PG8_LDB(B1, 0, 1); PG8_SCHED; PG8_LDA(At, 0, 0); PG8_STAGE(PG8_SA(1, 1), a1 + hstep, voffA);
            PG8_WAIT_V(8); PG8_WAIT_L(0); PG8_BAR; PG8_MMA(0, 0, At, B0); PG8_MMA(0, 1, At, B1); PG8_BAR; PG8_SCHED;
            PG8_LDA(At, 0, 1); PG8_STAGE(PG8_SB(0, 0), b2, voffB); PG8_STAGE(PG8_SB(0, 1), b2 + hstep, voffB); PG8_STAGE(PG8_SA(0, 0), a2, voffA);
            PG8_WAIT_V(8); PG8_WAIT_L(0); PG8_BAR; PG8_MMA(1, 0, At, B0); PG8_MMA(1, 1, At, B1); PG8_BAR; PG8_SCHED;
            PG8_LDB(B0, 1, 0); PG8_LDB(B1, 1, 1); PG8_SCHED; PG8_LDA(At, 1, 0); PG8_STAGE(PG8_SA(0, 1), a2 + hstep, voffA);
            PG8_WAIT_V(8); PG8_WAIT_L(0); PG8_BAR; PG8_MMA(0, 0, At, B0); PG8_MMA(0, 1, At, B1); PG8_BAR; PG8_SCHED;
            PG8_LDA(At, 1, 1); PG8_STAGE(PG8_SB(1, 0), b3, voffB); PG8_STAGE(PG8_SB(1, 1), b3 + hstep, voffB); PG8_STAGE(PG8_SA(1, 0), a3, voffA);
            PG8_WAIT_V(8); PG8_WAIT_L(0); PG8_BAR; PG8_MMA(1, 0, At, B0); PG8_MMA(1, 1, At, B1); PG8_BAR; PG8_SCHED;
            } else {
            PG8_LDB(B0, 0, 0); PG8_SCHED; PG8_LDA(At, 0, 0); PG8_STAGE(PG8_SA(1, 1), a1 + hstep, voffA);
            PG8_WAIT_L(8); PG8_BAR; PG8_WAIT_L(0); PG8_MMA(0, 0, At, B0); PG8_BAR; PG8_SCHED;
            PG8_LDB(B1, 0, 1); PG8_STAGE(PG8_SB(0, 0), b2, voffB);
            PG8_BAR; PG8_WAIT_L(0); PG8_MMA(0, 1, At, B1); PG8_BAR;
            PG8_LDA(At, 0, 1); PG8_STAGE(PG8_SA(0, 0), a2, voffA);
            PG8_BAR; PG8_WAIT_L(0); PG8_MMA(1, 0, At, B0); PG8_BAR; PG8_SCHED;
            PG8_STAGE(PG8_SB(0, 1), b2 + hstep, voffB);
            PG8_WAIT_V(6); PG8_BAR; PG8_MMA(1, 1, At, B1); PG8_BAR;
            PG8_LDB(B0, 1, 0); PG8_SCHED; PG8_LDA(At, 1, 0); PG8_STAGE(PG8_SA(0, 1), a2 + hstep, voffA);
            PG8_WAIT_L(8); PG8_BAR; PG8_WAIT_L(0); PG8_MMA(0, 0, At, B0); PG8_BAR; PG8_SCHED;
            PG8_LDB(B1, 1, 1); PG8_STAGE(PG8_SB(1, 0), b3, voffB);
            PG8_BAR; PG8_WAIT_L(0); PG8_MMA(0, 1, At, B1); PG8_BAR;
            PG8_LDA(At, 1, 1); PG8_STAGE(PG8_SA(1, 0), a3, voffA);
            PG8_BAR; PG8_WAIT_L(0); PG8_MMA(1, 0, At, B0); PG8_BAR; PG8_SCHED;
            PG8_STAGE(PG8_SB(1, 1), b3 + hstep, voffB);
            PG8_WAIT_V(6); PG8_BAR; PG8_MMA(1, 1, At, B1); PG8_BAR;
            }
        }
        if constexpr (ALIGN_EPI) { if (wr == 0) PG8_BAR; }
        if constexpr (!Epi::AFTER_DRAIN) { E(acc, cur, wr, wc, fr, fq); S.done(cur); }
        if (!has_next) break;
        if (!(Epi::MID && cur.kh == 0)) {
#pragma unroll
        for (int a = 0; a < 2; ++a)
#pragma unroll
            for (int b = 0; b < 2; ++b)
#pragma unroll
                for (int m = 0; m < 4; ++m)
#pragma unroll
                    for (int n = 0; n < 2; ++n) acc[a][b][m][n] = (f32x4){0.f, 0.f, 0.f, 0.f};
        }
        cur = nxt; cA = nA; cB = nB; ++ui;
        if constexpr (ALIGN_EPI) { if (wr == 1) PG8_BAR; }
    }
    PG8_WAIT_V(0);
    if constexpr (!ALIGN_EPI) { if (wr == 0) PG8_BAR; }
    PG8_BAR;
    if constexpr (Epi::AFTER_DRAIN) { E.fused(acc, cur, wr, wc, fr, fq, lds, wid, lane); S.done(cur); }
#undef PG8_SA
#undef PG8_SB
#undef PG8_STAGE
#undef PG8_LDA
#undef PG8_LDB
#undef PG8_MMA
#undef PG8_WAIT_V
#undef PG8_WAIT_L
#undef PG8_BAR
#undef PG8_SCHED
}
}

namespace attn {
constexpr int D = 128;
constexpr float THR = 8.f;
constexpr bool WSKIP = false;
constexpr int LDP = 16384, LDO = 2048;
constexpr float SCALE = 0.08838834764831845f;
constexpr int NW = 8, QBLK = 32, KVBLK = 64, QB = NW * QBLK;
constexpr int SHM_V = KVBLK * D * 2, SHM_K = KVBLK * D * 2;
constexpr int LDS_BYTES = 2 * SHM_V + 2 * SHM_K + NW * 64 * 4;

using bf16 = __hip_bfloat16;
typedef short bf16x8 __attribute__((ext_vector_type(8)));
typedef short s16x4 __attribute__((ext_vector_type(4)));
typedef float f32x16 __attribute__((ext_vector_type(16)));
typedef float f32x4 __attribute__((ext_vector_type(4)));
typedef unsigned u32x4 __attribute__((ext_vector_type(4)));
template <class A, class Bt> struct same_t { static constexpr bool v = false; };
template <class A> struct same_t<A, A> { static constexpr bool v = true; };

#define KSWZ(row, colB) ((row) * 256 + ((colB) ^ (((row) & 7) << 4)))
#define SBAR() __builtin_amdgcn_sched_barrier(0)
__device__ __forceinline__ int v_st(int k, int c) { const int kk = (k & ~0xC) | ((k & 4) << 1) | ((k & 8) >> 1); return ((kk >> 3) * 4 + (c >> 5)) * 512 + ((kk & 7) * 32 + (c & 31)) * 2; }
__device__ __forceinline__ int v_rd_base(int lane) { return ((lane & 3) << 3) | (((lane >> 2) & 3) << 6) | (((lane >> 4) & 1) << 5) | (((lane >> 5) & 1) << 8); }
constexpr int v_rd_off(int d0, int ks, int half) { return d0 * 512 + ks * 4096 + half * 2048; }
__device__ __forceinline__ int crow(int r, int hi) { return (r & 3) + 8 * (r >> 2) + 4 * hi; }
__device__ __forceinline__ unsigned cvtpk(float lo, float hi) {
    unsigned r; asm volatile("v_cvt_pk_bf16_f32 %0, %1, %2" : "=v"(r) : "v"(lo), "v"(hi)); return r;
}
__device__ __forceinline__ bf16x8 pack8(f32x4 a, f32x4 b) {
    u32x4 w = {cvtpk(a[0], a[1]), cvtpk(a[2], a[3]), cvtpk(b[0], b[1]), cvtpk(b[2], b[3])};
    return *reinterpret_cast<bf16x8*>(&w);
}
template <class T> __device__ __forceinline__ bf16x8 load8(const T* p) {
    if constexpr (same_t<T, float>::v) { return pack8(*(const f32x4*)p, *(const f32x4*)(p + 4)); }
    else { return *reinterpret_cast<const bf16x8*>(p); }
}
__device__ __forceinline__ void mask_tile(f32x16& p0, f32x16& p1, int dq, unsigned W) {
    const float NEG = -__builtin_inff();
#pragma unroll
    for (int r = 0; r < 16; ++r) {
        const int c = (r & 3) + 8 * (r >> 2);
        if ((unsigned)(dq - c) >= W) p0[r] = NEG;
        if ((unsigned)(dq - c - 32) >= W) p1[r] = NEG;
    }
}
__device__ __forceinline__ void partialSM(f32x16& p0, f32x16& p1, float& m_reg, float& mn, float& alpha) {
    float pmax = p0[0]; for (int r = 1; r < 16; ++r) pmax = fmaxf(pmax, p0[r]); for (int r = 0; r < 16; ++r) pmax = fmaxf(pmax, p1[r]);
    { auto rr = __builtin_amdgcn_permlane32_swap(__float_as_uint(pmax), __float_as_uint(pmax), false, false);
      pmax = fmaxf(__uint_as_float(rr[0]), __uint_as_float(rr[1])); }
    constexpr float C2 = 1.4426950408889634f * SCALE;
    if (__builtin_expect(__all((pmax - m_reg) * SCALE <= THR), 1)) { mn = m_reg; alpha = 1.f; }
    else { mn = fmaxf(m_reg, pmax); alpha = __builtin_amdgcn_exp2f((m_reg - mn) * C2); m_reg = mn; }
    const float mnL = -mn * C2;
    for (int r = 0; r < 16; ++r) p0[r] = fmaf(p0[r], C2, mnL); for (int r = 0; r < 16; ++r) p1[r] = fmaf(p1[r], C2, mnL);
    for (int r = 0; r < 16; ++r) p0[r] = __builtin_amdgcn_exp2f(p0[r]);
}
__device__ __forceinline__ void finishSM(f32x16& p0, f32x16& p1, float alpha, float& l_reg, bf16x8& pa0, bf16x8& pa1, bf16x8& pa2, bf16x8& pa3) {
    for (int r = 0; r < 16; ++r) p1[r] = __builtin_amdgcn_exp2f(p1[r]);
    float ps = 0; for (int r = 0; r < 16; ++r) ps += p0[r]; for (int r = 0; r < 16; ++r) ps += p1[r];
    { auto rr = __builtin_amdgcn_permlane32_swap(__float_as_uint(ps), __float_as_uint(ps), false, false);
      ps = __uint_as_float(rr[0]) + __uint_as_float(rr[1]); }
    l_reg = l_reg * alpha + ps;
#define PK4(P, B_, OUT) do { unsigned a0 = cvtpk(P[B_+0], P[B_+1]), a1 = cvtpk(P[B_+2], P[B_+3]);                          \
        unsigned b0 = cvtpk(P[B_+4], P[B_+5]), b1 = cvtpk(P[B_+6], P[B_+7]);                                             \
        auto r0 = __builtin_amdgcn_permlane32_swap(a0, b0, false, false); auto r1 = __builtin_amdgcn_permlane32_swap(a1, b1, false, false); \
        u32x4 w = {r0[0], r1[0], r0[1], r1[1]}; OUT = *reinterpret_cast<bf16x8*>(&w); } while (0)
    PK4(p0, 0, pa0); PK4(p0, 8, pa1); PK4(p1, 0, pa2); PK4(p1, 8, pa3);
#undef PK4
}
template <int KB, bool SK>
__device__ __forceinline__ void qkt(f32x16& p0, f32x16& p1, const char* K_lds, int r32, int hi, const bf16x8* qr, bool act) {
    if (SK && !act) { const float NEG = -__builtin_inff();
#pragma unroll
        for (int r = 0; r < 16; ++r) { p0[r] = NEG; p1[r] = NEG; } return; }
    p0 = f32x16{}; p1 = f32x16{};
    const char* kb[4];
#pragma unroll
    for (int dd = 0; dd < 4; ++dd) kb[dd] = K_lds + KB * SHM_K + KSWZ(r32, (dd * 16 + hi * 8) * 2);
#pragma unroll
    for (int d0 = 0; d0 < 8; ++d0) { const char* a = kb[d0 & 3] + (d0 >> 2) * 128;
        bf16x8 b0 = *reinterpret_cast<const bf16x8*>(a);
        bf16x8 b1 = *reinterpret_cast<const bf16x8*>(a + 32 * 256);
        p0 = __builtin_amdgcn_mfma_f32_32x32x16_bf16(b0, qr[d0], p0, 0, 0, 0);
        p1 = __builtin_amdgcn_mfma_f32_32x32x16_bf16(b1, qr[d0], p1, 0, 0, 0); }
}
template <int KB>
__device__ __forceinline__ void qkt2(f32x16& p0, f32x16& p1, int ka0, int ka1, int ka2, int ka3, const bf16x8* qr) {
#define KRD(dst, a, off) asm volatile("ds_read_b128 %0, %1 offset:%2" : "=&v"(dst) : "v"(a), "i"(off) : "memory")
#define KRD4(S, aE, aO, g) do { constexpr int o_ = KB * SHM_K + ((g) >> 1) * 128;     \
        KRD(S##0, aE, o_); KRD(S##1, aE, o_ + 8192); KRD(S##2, aO, o_); KRD(S##3, aO, o_ + 8192); } while (0)
#define KMM(S, g) do { p0 = __builtin_amdgcn_mfma_f32_32x32x16_bf16(S##0, qr[2 * (g)], p0, 0, 0, 0); p1 = __builtin_amdgcn_mfma_f32_32x32x16_bf16(S##1, qr[2 * (g)], p1, 0, 0, 0); \
        p0 = __builtin_amdgcn_mfma_f32_32x32x16_bf16(S##2, qr[2 * (g) + 1], p0, 0, 0, 0); p1 = __builtin_amdgcn_mfma_f32_32x32x16_bf16(S##3, qr[2 * (g) + 1], p1, 0, 0, 0); } while (0)
#define KW(n) do { asm volatile("s_waitcnt lgkmcnt(" #n ")" ::: "memory"); SBAR(); } while (0)
    bf16x8 X0, X1, X2, X3, Y0, Y1, Y2, Y3;
    p0 = f32x16{}; p1 = f32x16{};
    KRD4(X, ka0, ka1, 0);
    KRD4(Y, ka2, ka3, 1); KW(4); KMM(X, 0);
    KRD4(X, ka0, ka1, 2); KW(4); KMM(Y, 1);
    KRD4(Y, ka2, ka3, 3); KW(4); KMM(X, 2);
    KW(0); KMM(Y, 3);
#undef KRD
#undef KRD4
#undef KMM
#undef KW
}
template <int VB, bool SK>
__device__ __forceinline__ void pv_tile(f32x16* o, int vb0, bf16x8 pa0, bf16x8 pa1, bf16x8 pa2, bf16x8 pa3, bool act) {
    if (SK && !act) return;
#define TRRD(dst, off) asm volatile("ds_read_b64_tr_b16 %0, %1 offset:%2" : "=&v"(dst) : "v"(vb0), "i"(off) : "memory")
#define PV_D0(d0) do { s16x4 l0, l1, l2, l3, h0, h1, h2, h3; constexpr int b_ = VB * SHM_V + v_rd_off(d0, 0, 0);     \
        TRRD(l0, b_); TRRD(h0, b_ + 2048); TRRD(l1, b_ + 4096); TRRD(h1, b_ + 6144); TRRD(l2, b_ + 8192); TRRD(h2, b_ + 10240); TRRD(l3, b_ + 12288); TRRD(h3, b_ + 14336); \
        asm volatile("s_waitcnt lgkmcnt(0)" ::: "memory"); SBAR();                 \
        o[d0] = __builtin_amdgcn_mfma_f32_32x32x16_bf16(pa0, (bf16x8){l0[0], l0[1], l0[2], l0[3], h0[0], h0[1], h0[2], h0[3]}, o[d0], 0, 0, 0);   \
        o[d0] = __builtin_amdgcn_mfma_f32_32x32x16_bf16(pa1, (bf16x8){l1[0], l1[1], l1[2], l1[3], h1[0], h1[1], h1[2], h1[3]}, o[d0], 0, 0, 0);   \
        o[d0] = __builtin_amdgcn_mfma_f32_32x32x16_bf16(pa2, (bf16x8){l2[0], l2[1], l2[2], l2[3], h2[0], h2[1], h2[2], h2[3]}, o[d0], 0, 0, 0);   \
        o[d0] = __builtin_amdgcn_mfma_f32_32x32x16_bf16(pa3, (bf16x8){l3[0], l3[1], l3[2], l3[3], h3[0], h3[1], h3[2], h3[3]}, o[d0], 0, 0, 0); } while (0)
    PV_D0(0); PV_D0(1); PV_D0(2); PV_D0(3);
#undef PV_D0
#undef TRRD
}

template <class TIn, class TOut> struct BlockRef { const TIn* Q; const TIn* K; const TIn* V; TOut* O; int P0; };
template <class TIn> struct Seam {
    bf16x8 qr[8];
    bf16x8 st_v0, st_v1, st_k0, st_k1; f32x4 sf0, sf1, sf2, sf3;
    f32x4 tq[16];
};
__device__ __forceinline__ int swa_jlo(int P0, int W) { const int lowk = P0 - W + 1; return lowk > 0 ? lowk / KVBLK : 0; }
#define ROW(p, k0, rr) ((p) + (size_t)((k0) + (rr)) * LDP + sc)
#define VMW() asm volatile("s_waitcnt vmcnt(0)" ::: "memory")
#define VMWN(n) asm volatile("s_waitcnt vmcnt(%0)" :: "i"(n) : "memory")
#define UPTR(p, off) ((const TIn*)((const char*)(p) + (unsigned)(off)))
#define SLOAD_H(Kp, Vp, k0) do { const TIn* kb_ = (Kp) + (size_t)(k0) * LDP; const TIn* vb_ = (Vp) + (size_t)(k0) * LDP;                     \
                         S.st_v0 = load8<TIn>(UPTR(vb_, toff)); S.st_v1 = load8<TIn>(UPTR(vb_ + 32 * LDP, toff));              \
                         S.st_k0 = load8<TIn>(UPTR(kb_, toff)); S.st_k1 = load8<TIn>(UPTR(kb_ + 32 * LDP, toff)); } while (0)
#define SWRITE_HK(bf) do { *(bf16x8*)(K_lds + (bf) * SHM_K + kws) = S.st_k0; *(bf16x8*)(K_lds + (bf) * SHM_K + kws + 32 * 256) = S.st_k1; } while (0)
#define SWRITE_HV(bf) do { *(bf16x8*)(V_lds + (bf) * SHM_V + vst0) = S.st_v0; *(bf16x8*)(V_lds + (bf) * SHM_V + vst1) = S.st_v1; } while (0)
#define SWRITE_H(bf) do { SWRITE_HV(bf); SWRITE_HK(bf); } while (0)
#define SLOAD_F(p, k0) do { S.sf0 = *(const f32x4*)ROW(p, k0, sr); S.sf1 = *(const f32x4*)(ROW(p, k0, sr) + 4);                \
                            S.sf2 = *(const f32x4*)ROW(p, k0, 32 + sr); S.sf3 = *(const f32x4*)(ROW(p, k0, 32 + sr) + 4); } while (0)
#define SWRITE_KF(bf) do { *(bf16x8*)(K_lds + (bf) * SHM_K + kws) = pack8(S.sf0, S.sf1); *(bf16x8*)(K_lds + (bf) * SHM_K + kws + 32 * 256) = pack8(S.sf2, S.sf3); } while (0)
#define SWRITE_VF(bf) do { *(bf16x8*)(V_lds + (bf) * SHM_V + vst0) = pack8(S.sf0, S.sf1); *(bf16x8*)(V_lds + (bf) * SHM_V + vst1) = pack8(S.sf2, S.sf3); } while (0)
template <class TIn, class TOut>
__device__ __forceinline__ void causal_swa_prime(const BlockRef<TIn, TOut>& cur, int W, char* lds, Seam<TIn>& S) {
    constexpr bool F32 = same_t<TIn, float>::v;
    const int tid = tidx(), wid = __builtin_amdgcn_readfirstlane(tid >> 6), lane = tid & 63, r32 = lane & 31, hi = lane >> 5;
    const int sr = tid >> 4, sc = (tid & 15) * 8, kws = KSWZ(sr, sc * 2); char* K_lds = lds + 2 * SHM_V; const unsigned toff = (unsigned)(sr * LDP + sc) * 2u;
    const int kb0 = swa_jlo(cur.P0, W) * KVBLK;
    for (int d0 = 0; d0 < 8; ++d0) S.qr[d0] = load8<TIn>(UPTR(cur.Q + (size_t)(wid * QBLK) * LDP + d0 * 16, (unsigned)(r32 * LDP + hi * 8) * 2u));
    if constexpr (F32) { SLOAD_F((const float*)cur.K, kb0); VMW(); SWRITE_KF(0); SBAR(); SLOAD_F((const float*)cur.V, kb0); }
    else { SLOAD_H(cur.K, cur.V, kb0); VMW(); SWRITE_HK(0); }
    __syncthreads();
}
template <class TIn, class TOut>
__device__ __forceinline__ void causal_swa_block(const BlockRef<TIn, TOut>& cur, const BlockRef<TIn, TOut>& nxt, int skv, int W, char* lds, Seam<TIn>& S) {
    constexpr bool F32 = same_t<TIn, float>::v;
    const int tid = tidx(), wid = __builtin_amdgcn_readfirstlane(tid >> 6), lane = tid & 63, r32 = lane & 31, hi = lane >> 5;
    const int j_lo = swa_jlo(cur.P0, W);
    int j_hi = (cur.P0 + QB - 1) / KVBLK + 1; if (j_hi > skv / KVBLK) j_hi = skv / KVBLK;
    const int NT = j_hi - j_lo;
    const int kbn = swa_jlo(nxt.P0, W) * KVBLK;
    const int qlo = cur.P0 + wid * QBLK, qm = qlo + r32 - 4 * hi;
    char* V_lds = lds; char* K_lds = lds + 2 * SHM_V;
    float* ws = (float*)(lds + 2 * SHM_V + 2 * SHM_K) + wid * 64; float* li_l = ws, * al_l = ws + 32;
    float m_reg = -1e30f, l_reg = 0; f32x16 o[4] = {};
    const int sr = tid >> 4, sc = (tid & 15) * 8, vst0 = v_st(sr, sc), vst1 = vst0 + 8192  , kws = KSWZ(sr, sc * 2); const unsigned toff = (unsigned)(sr * LDP + sc) * 2u;
    const int vb0 = (int)(uintptr_t)V_lds + v_rd_base(lane);
    const TIn* Kh = cur.K; const TIn* Vh = cur.V;
#define RESC(a) do { if (__any((a) < 1.f)) { if (hi == 0) al_l[r32] = (a); asm volatile("s_waitcnt lgkmcnt(0)" ::: "memory");              \
                     for (int d_ = 0; d_ < 4; ++d_) for (int r = 0; r < 16; ++r) o[d_][r] *= al_l[crow(r, hi)]; } } while (0)
#define KBASE(t) ((j_lo + (t)) * KVBLK)
#define ACT(t) (KBASE(t) <= qlo + QBLK - 1 && KBASE(t) + KVBLK - 1 >= qlo - W + 1)
#define MASKT(P0_, P1_, t) do { const int kb_ = KBASE(t); if ((!SK || ACT(t)) && (kb_ + KVBLK - 1 > qlo || kb_ <= qlo + QBLK - 1 - W)) mask_tile(P0_, P1_, qm - kb_, (unsigned)W); } while (0)
    constexpr int NQL = F32 ? 16 : 8;
    constexpr bool SK = WSKIP && !F32;
#define SEAM_K0() do { VMWN(NQL); if constexpr (F32) { SWRITE_KF(0); SBAR(); SLOAD_F((const float*)nxt.V, kbn); } else { SWRITE_HK(0); } SBAR(); } while (0)
    f32x16 pA0, pA1, pB0, pB1; float mnA, mnB, alA, alB; bf16x8 pa0, pa1, pa2, pa3;
    if constexpr (F32) { VMW(); SWRITE_VF(0); SBAR(); } else { SWRITE_HV(0); SBAR(); }
    if (NT > 1) { if constexpr (F32) SLOAD_F((const float*)Kh, KBASE(1)); else SLOAD_H(Kh, Vh, KBASE(1)); }
    SBAR(); qkt<0, SK>(pA0, pA1, K_lds, r32, hi, S.qr, ACT(0));
    if constexpr (F32) { if (NT > 1) { VMW(); SWRITE_KF(1); SBAR(); SLOAD_F((const float*)Vh, KBASE(1)); } }
    MASKT(pA0, pA1, 0); partialSM(pA0, pA1, m_reg, mnA, alA);
    if (NT > 1) { VMW(); if constexpr (F32) { SWRITE_VF(1); SBAR(); if (NT > 2) SLOAD_F((const float*)Kh, KBASE(2)); } else SWRITE_H(1); }
    __syncthreads();
#define HALF_STEP(PX0, PX1, mnX, alX, PY0, PY1, alY, t, KB, VB, SB) do {                                                      \
        SBAR(); qkt<KB, SK>(PX0, PX1, K_lds, r32, hi, S.qr, ACT(t));                                             \
        finishSM(PY0, PY1, alY, l_reg, pa0, pa1, pa2, pa3); SBAR();                                                           \
        if ((t) + 1 < NT) { if constexpr (F32) { VMW(); SWRITE_KF(SB); SBAR(); SLOAD_F((const float*)Vh, KBASE((t) + 1)); }  \
                            else { SLOAD_H(Kh, Vh, KBASE((t) + 1)); } SBAR(); }                                               \
        pv_tile<VB, SK>(o, vb0, pa0, pa1, pa2, pa3, ACT((t) - 1)); MASKT(PX0, PX1, (t)); partialSM(PX0, PX1, m_reg, mnX, alX);                                        \
        __syncthreads();                                                                                                      \
        if ((t) + 1 < NT) { VMW(); if constexpr (F32) { SWRITE_VF(SB); SBAR(); if ((t) + 2 < NT) SLOAD_F((const float*)Kh, KBASE((t) + 2)); } \
                            else { SWRITE_H(SB); } }                                                                          \
        RESC(alX); __syncthreads(); } while (0)
    for (int t = 1; t + 1 < NT; t += 2) {
        HALF_STEP(pB0, pB1, mnB, alB, pA0, pA1, alA, t, 1, 0, 0);
        HALF_STEP(pA0, pA1, mnA, alA, pB0, pB1, alB, t + 1, 0, 1, 1);
    }
    const bool even = (NT & 1) == 0;
    if (even) { SBAR(); qkt<1, SK>(pB0, pB1, K_lds, r32, hi, S.qr, ACT(NT - 1)); SBAR(); }
#define QROW(e) (nxt.Q + (size_t)(wid * QBLK + r32) * LDP + ((e) >> 1) * 16 + hi * 8 + ((e) & 1) * 4)
    if constexpr (F32) { SLOAD_F((const float*)nxt.K, kbn); SBAR();
#pragma unroll
        for (int e = 0; e < 8; ++e) S.tq[e] = *(const f32x4*)QROW(e); }
    else { SLOAD_H(nxt.K, nxt.V, kbn); SBAR();
#pragma unroll
        for (int d0 = 0; d0 < 8; ++d0) S.qr[d0] = load8<TIn>(UPTR(nxt.Q + (size_t)(wid * QBLK) * LDP + d0 * 16, (unsigned)(r32 * LDP + hi * 8) * 2u)); }
    SBAR();
    finishSM(pA0, pA1, alA, l_reg, pa0, pa1, pa2, pa3); SBAR();
    if constexpr (F32) {
#pragma unroll
        for (int e = 8; e < 16; ++e) S.tq[e] = *(const f32x4*)QROW(e); SBAR(); }
#undef QROW
    pv_tile<0, SK>(o, vb0, pa0, pa1, pa2, pa3, ACT(even ? NT - 2 : NT - 1));
    if (even) { MASKT(pB0, pB1, NT - 1); partialSM(pB0, pB1, m_reg, mnB, alB); __syncthreads(); RESC(alB);
        finishSM(pB0, pB1, alB, l_reg, pa0, pa1, pa2, pa3); SBAR(); pv_tile<1, SK>(o, vb0, pa0, pa1, pa2, pa3, ACT(NT - 1)); }
    SBAR(); SEAM_K0();
    if (hi == 0) li_l[r32] = l_reg; asm volatile("s_waitcnt lgkmcnt(0)" ::: "memory");
    float rli[16];
#pragma unroll
    for (int r = 0; r < 16; ++r) rli[r] = __builtin_amdgcn_rcpf(li_l[crow(r, hi)]);
    TOut* Ow = cur.O + (size_t)(wid * QBLK) * LDO;
#pragma unroll
    for (int r = 0; r < 16; ++r) { const int orow = crow(r, hi);
#pragma unroll
        for (int d0 = 0; d0 < 4; ++d0) { const float v = o[d0][r] * rli[r];
            if constexpr (same_t<TOut, float>::v) { Ow[(size_t)orow * LDO + d0 * 32 + r32] = v; }
            else { const float vn = __builtin_bit_cast(float, __builtin_amdgcn_update_dpp(0, __builtin_bit_cast(int, v), 0xB1, 0xf, 0xf, false));
                   if ((r32 & 1) == 0) *(unsigned*)(Ow + (size_t)orow * LDO + d0 * 32 + r32) = cvtpk(v, vn); } } }
    if constexpr (F32) {
#pragma unroll
        for (int d0 = 0; d0 < 8; ++d0) S.qr[d0] = pack8(S.tq[2 * d0], S.tq[2 * d0 + 1]); }
    __syncthreads();
#undef RESC
#undef KBASE
#undef ACT
#undef MASKT
#undef SEAM_K0
#undef HALF_STEP
}
#undef ROW
#undef VMW
#undef VMWN
#undef SLOAD_H
#undef UPTR
#undef SWRITE_HK
#undef SWRITE_HV
#undef SWRITE_H
#undef SLOAD_F
#undef SWRITE_KF
#undef SWRITE_VF

#undef KSWZ
#undef SBAR
}

#define GAS __attribute__((address_space(1)))
#define LAS __attribute__((address_space(3)))
typedef unsigned short bf16;
typedef unsigned v4u __attribute__((ext_vector_type(4)));
typedef float f32x4 __attribute__((ext_vector_type(4)));
typedef short bf16x8 __attribute__((ext_vector_type(8)));
typedef GAS unsigned gu32;
typedef GAS unsigned long long gu64;
#define RLX_AGENT __ATOMIC_RELAXED, __HIP_MEMORY_SCOPE_AGENT
#define LDS_WAIT() asm volatile("s_waitcnt lgkmcnt(0)" ::: "memory")
#define VM_WAIT() asm volatile("s_waitcnt vmcnt(0)" ::: "memory")
__device__ __forceinline__ unsigned long long rt() { return __builtin_amdgcn_s_memrealtime(); }
__device__ __forceinline__ unsigned f2bf(float f) { unsigned u = __builtin_bit_cast(unsigned, f); return (u + 0x7fffu + ((u >> 16) & 1u)) >> 16; }
__device__ __forceinline__ unsigned pk2(float lo, float hi) { return f2bf(lo) | (f2bf(hi) << 16); }

#define XB_TMO      128
#define XB_XCNT(j)  (256  + 64 * (j))
#define XB_XSUB(j)  (1280 + 64 * (j))
#define XB_XGEN(j)  (2304 + 64 * (j))
#define XB_TOP      3328
#define XB_TOPGEN   3392
#define XCD_BAR_WORDS 3456
#define XB_SPIN_CAP (1u << 18)

__device__ __forceinline__ unsigned xb_ld(unsigned* p)              { return __hip_atomic_load(p, __ATOMIC_RELAXED, __HIP_MEMORY_SCOPE_AGENT); }
__device__ __forceinline__ unsigned xb_add(unsigned* p, unsigned v) { return __hip_atomic_fetch_add(p, v, __ATOMIC_RELAXED, __HIP_MEMORY_SCOPE_AGENT); }
__device__ __forceinline__ unsigned xb_xcc_id() { return (unsigned)__builtin_amdgcn_s_getreg((3 << 11) | 20) & 0xFu; }
#define XB_SPIN(cond, bar) do { unsigned _sp = 0; while (cond) { __builtin_amdgcn_s_sleep(1); \
    if ((++_sp & 255u) == 0u) { if (xb_ld(&(bar)[XB_TMO])) break; if (_sp > XB_SPIN_CAP) { atomicAdd(&(bar)[XB_TMO], 1u); break; } } } } while (0)

struct XcdBarrier {
    unsigned* bar; unsigned x;
    volatile LAS unsigned* st;
};

__device__ __forceinline__ XcdBarrier xcd_barrier_post(unsigned* bar, volatile LAS unsigned* st) {
    XcdBarrier b; b.bar = bar; b.x = xb_xcc_id(); b.st = st;
    if (tidx() == 0) (void)xb_add(&bar[XB_XCNT(b.x)], 1u);
    return b;
}
__device__ __forceinline__ void xcd_barrier_complete(unsigned* bar, unsigned x, unsigned& nloc, unsigned& nx) {
    const unsigned G = gridDim.x * gridDim.y * gridDim.z;
    unsigned sum, cnt, mine, sp = 0u;
    for (;;) {
        sum = 0u; cnt = 0u; mine = 0u;
#pragma unroll
        for (unsigned j = 0; j < 16; ++j) { const unsigned c = xb_ld(&bar[XB_XCNT(j)]); sum += c; cnt += (c > 0u) ? 1u : 0u; mine = (j == x) ? c : mine; }
        if (sum == G) break;
        __builtin_amdgcn_s_sleep(1);
        if ((++sp & 255u) == 0u) { if (xb_ld(&bar[XB_TMO])) break; if (sp > XB_SPIN_CAP) { atomicAdd(&bar[XB_TMO], 1u); break; } }
    }
    nloc = mine > 0u ? mine : 1u; nx = cnt > 0u ? cnt : 1u;
}

__device__ __forceinline__ void xcd_barrier(const XcdBarrier& b) {
    asm volatile("s_waitcnt vmcnt(0)" ::: "memory");
    __syncthreads();
    if (tidx() == 0) {
        unsigned* bar = b.bar;
        __builtin_amdgcn_s_waitcnt(0);
        unsigned nloc = b.st[0], nx = b.st[1];
        if (nloc == 0u) { xcd_barrier_complete(bar, b.x, nloc, nx); b.st[0] = nloc; b.st[1] = nx; }
        const unsigned old = xb_add(&bar[XB_XSUB(b.x)], 1u);
        const unsigned gen = old / nloc;
        if (old + 1u == (gen + 1u) * nloc) {
            __builtin_amdgcn_fence(__ATOMIC_RELEASE, "agent");
            asm volatile("s_waitcnt vmcnt(0)" ::: "memory");
            const unsigned og = xb_add(&bar[XB_TOP], 1u);
            const unsigned tg = og / nx;
            if (og + 1u == (tg + 1u) * nx) xb_add(&bar[XB_TOPGEN], 1u);
            else XB_SPIN(xb_ld(&bar[XB_TOPGEN]) == tg, bar);
            __builtin_amdgcn_fence(__ATOMIC_ACQUIRE, "agent");
            xb_add(&bar[XB_XGEN(b.x)], 1u);
            asm volatile("s_waitcnt vmcnt(0)" ::: "memory");
        } else {
            XB_SPIN(xb_ld(&bar[XB_XGEN(b.x)]) == gen, bar);
            __builtin_amdgcn_fence(__ATOMIC_ACQUIRE, "agent");
            asm volatile("s_waitcnt vmcnt(0)" ::: "memory");
        }
    }
    __syncthreads();
}

constexpr int DM = 2048, NBATCH = 4, SEQ = 4096, DEPTH = 4, MTOK = NBATCH * SEQ;
constexpr int N_IN = 16400, NP = 16384, DFF = 5632, NHEAD = 8;
constexpr float EPS = 1e-6f;
constexpr int C_MQ = 0, C_MK = 1024, C_MV = 2048, C_MO = 4096, C_DQ = 6144, C_DK = 8192, C_DV = 10240, C_GM = 12288, C_GD = 14336;
constexpr int SRC_GATE = 6144;

constexpr size_t MiB = 1u << 20;
constexpr size_t WS_CTL = 0, CTL_ZERO_BYTES = 1 * MiB;
constexpr size_t WS_W1 = 1 * MiB;
constexpr size_t WS_W2 = 65 * MiB;
constexpr size_t WS_W3 = 81 * MiB;
constexpr size_t WS_W4 = 89 * MiB;
constexpr size_t WS_W5 = 133 * MiB;
constexpr size_t WS_X = 156 * MiB;
constexpr size_t WS_HB = 284 * MiB;
constexpr size_t WS_G = 348 * MiB;
constexpr size_t WS_SSQ = 349 * MiB;
constexpr size_t WS_HMF = 413 * MiB;
constexpr size_t WS_HD1 = 541 * MiB;
constexpr size_t WS_HD2 = 669 * MiB;
constexpr size_t WS_HMD = 797 * MiB;
constexpr size_t WS_Y = 925 * MiB;
constexpr size_t WS_P = 989 * MiB;
constexpr size_t WS_END = 1501 * MiB;
constexpr int CW_BAR = 4096;
constexpr int CW_Q = 8192;

constexpr int RING_BYTES = 147456, LDSCTL_OFF = RING_BYTES, MISC_OFF = LDSCTL_OFF + 320, PTR_OFF = LDSCTL_OFF + 1024, RT_OFF = LDSCTL_OFF + 2048  , LDS_BYTES = 163840;
constexpr int NWAVES = 8, NTHREADS = NWAVES * 64;
constexpr int MLSTM_WGS = 32;

__device__ __forceinline__ float bfbits2f(unsigned short h) { return __uint_as_float((unsigned)h << 16); }
__device__ __forceinline__ float wlo(unsigned w) { return __uint_as_float(w << 16); }
__device__ __forceinline__ float whi(unsigned w) { return __uint_as_float(w & 0xffff0000u); }
template <int CTRL> __device__ __forceinline__ float dpp_f(float x) { return __builtin_bit_cast(float, __builtin_amdgcn_update_dpp(0, __builtin_bit_cast(int, x), CTRL, 0xf, 0xf, false)); }
__device__ __forceinline__ float xor1_f(float v) { return dpp_f<0xB1>(v); }
__device__ __forceinline__ float sum4_f(float v) { v += dpp_f<0xB1>(v); v += dpp_f<0x4E>(v); return v; }
__device__ __forceinline__ float sum8_f(float v) { v = sum4_f(v); v += dpp_f<0x141>(v); return v; }
__device__ __forceinline__ float sum16_f(float v) { v = sum8_f(v); v += dpp_f<0x140>(v); return v; }
__device__ __forceinline__ float wave_sum(float v) {
    v = sum16_f(v);
    { auto r = __builtin_amdgcn_permlane16_swap(__float_as_uint(v), __float_as_uint(v), false, false); v = __uint_as_float(r[0]) + __uint_as_float(r[1]); }
    { auto r = __builtin_amdgcn_permlane32_swap(__float_as_uint(v), __float_as_uint(v), false, false); v = __uint_as_float(r[0]) + __uint_as_float(r[1]); }
    return v;
}
__device__ __forceinline__ float sigm(float x) { return __builtin_amdgcn_rcpf(1.0f + __expf(-x)); }
__device__ __forceinline__ float lam_init_of(int l) { return 0.8f - 0.6f * __expf(-0.3f * (float)l); }

__device__ __forceinline__ void tr_item(const float* W, int ldw, int scol0, int k0, const float* scale, float smul, bf16* WT, int ldt, LAS float* scr, int lane) {
    const int kr = lane >> 3, c4 = (lane & 7) * 4;
    f32x4 v[8]; float sc[8];
#pragma unroll
    for (int i = 0; i < 8; ++i) { v[i] = *(const GAS f32x4*)(W + (size_t)(k0 + 8 * i + kr) * ldw + scol0 + c4); sc[i] = scale ? scale[k0 + 8 * i + kr] * smul : 1.0f; }
#pragma unroll
    for (int i = 0; i < 8; ++i) { LAS float* d = scr + (8 * i + kr) * 33 + c4; d[0] = v[i].x * sc[i]; d[1] = v[i].y * sc[i]; d[2] = v[i].z * sc[i]; d[3] = v[i].w * sc[i]; }
    LDS_WAIT(); asm volatile("" ::: "memory");
    const int c = lane & 7;
#pragma unroll
    for (int j = 0; j < 4; ++j) { const int n = (lane >> 3) + 8 * j; const LAS float* s = scr + (8 * c) * 33 + n;
        v4u o; o.x = pk2(s[0 * 33], s[1 * 33]); o.y = pk2(s[2 * 33], s[3 * 33]); o.z = pk2(s[4 * 33], s[5 * 33]); o.w = pk2(s[6 * 33], s[7 * 33]);
        *(GAS v4u*)(WT + (size_t)n * ldt + k0 + 8 * c) = o; }
    LDS_WAIT(); asm volatile("" ::: "memory");
}

struct Args {
    const float* in[21]; float* out; unsigned char* ws;
    int l_lo, l_hi, ph_lo, ph_hi, do_final, use_bar, sub, qoff;
};
struct DArgs { LAS unsigned char* L; int l_lo, l_hi, ph_lo, ph_hi, do_final, use_bar, sub, qoff; };
__device__ __forceinline__ unsigned long long ptr_get(const DArgs& A, int i) {
    const unsigned long long v = ((const volatile LAS unsigned long long*)(A.L + PTR_OFF))[i];
    const unsigned lo = __builtin_amdgcn_readfirstlane((unsigned)v), hi = __builtin_amdgcn_readfirstlane((unsigned)(v >> 32));
    return ((unsigned long long)hi << 32) | lo;
}
__device__ __forceinline__ const float* inp(const DArgs& A, int i) { return (const float*)(const GAS float*)ptr_get(A, i); }
__device__ __forceinline__ float* outp(const DArgs& A) { return (float*)(GAS float*)ptr_get(A, 21); }
__device__ __forceinline__ unsigned char* wsp(const DArgs& A) { return (unsigned char*)(GAS unsigned char*)ptr_get(A, 22); }

struct WItem { const float* W; int ldw, scol0, k0; const float* scale; float smul; bf16* WT; int ldt; };
namespace wcv {
constexpr int I1 = (DM / 64) * (NP / 32), I2 = (DM / 64) * (DM / 32), I4 = (DM / 64) * (2 * DFF / 32), I5 = (DFF / 64) * (DM / 32);
constexpr int NITEMS = I1 + 3 * I2 + I4 + I5;
constexpr int NREST = NITEMS - I1;
}
__device__ __forceinline__ WItem weight_item(const DArgs& A, int l, int it) {
    using namespace wcv;
    unsigned char* ws = wsp(A); WItem w; int r = it;
    if (r < I1) { const int nblk = NP / 32, kb = r / nblk, nb = r % nblk, n0 = 32 * nb;
        w.W = inp(A, 2) + (size_t)l * DM * N_IN; w.ldw = N_IN; w.scol0 = n0 + (n0 >= SRC_GATE ? 16 : 0); w.k0 = 64 * kb; w.scale = inp(A, 1) + (size_t)l * DM; w.smul = 1.0f; w.WT = (bf16*)(ws + WS_W1) + (size_t)n0 * DM; w.ldt = DM; return w; } r -= I1;
    if (r < I2) { const int nblk = DM / 32, kb = r / nblk, nb = r % nblk, n0 = 32 * nb;
        w.W = inp(A, 13) + (size_t)l * DM * DM; w.ldw = DM; w.scol0 = n0; w.k0 = 64 * kb; w.scale = inp(A, 7) + (size_t)l * DM; w.smul = 1.0f; w.WT = (bf16*)(ws + WS_W2) + (size_t)n0 * (2 * DM); w.ldt = 2 * DM; return w; } r -= I2;
    if (r < I2) { const int nblk = DM / 32, kb = r / nblk, nb = r % nblk, n0 = 32 * nb;
        w.W = inp(A, 14) + (size_t)l * DM * DM; w.ldw = DM; w.scol0 = n0; w.k0 = 64 * kb; w.scale = inp(A, 12) + (size_t)l * DM; w.smul = 1.0f - lam_init_of(l); w.WT = (bf16*)(ws + WS_W2) + (size_t)n0 * (2 * DM) + DM; w.ldt = 2 * DM; return w; } r -= I2;
    if (r < I2) { const int nblk = DM / 32, kb = r / nblk, nb = r % nblk, n0 = 32 * nb;
        w.W = inp(A, 15) + (size_t)l * DM * DM; w.ldw = DM; w.scol0 = n0; w.k0 = 64 * kb; w.scale = nullptr; w.smul = 1.0f; w.WT = (bf16*)(ws + WS_W3) + (size_t)n0 * DM; w.ldt = DM; return w; } r -= I2;
    if (r < I4) { const int nblk = 2 * DFF / 32, kb = r / nblk, nb = r % nblk, n0 = 32 * nb, pn = n0 >> 8, j = n0 & 255;
        w.W = ((j < 128) ? inp(A, 17) : inp(A, 18)) + (size_t)l * DM * DFF; w.ldw = DFF; w.scol0 = pn * 128 + (j & 127); w.k0 = 64 * kb; w.scale = inp(A, 16) + (size_t)l * DM; w.smul = 1.0f; w.WT = (bf16*)(ws + WS_W4) + (size_t)n0 * DM; w.ldt = DM; return w; } r -= I4;
    { const int nblk = DM / 32, kb = r / nblk, nb = r % nblk, n0 = 32 * nb;
        w.W = inp(A, 19) + (size_t)l * DFF * DM; w.ldw = DM; w.scol0 = n0; w.k0 = 64 * kb; w.scale = nullptr; w.smul = 1.0f; w.WT = (bf16*)(ws + WS_W5) + (size_t)n0 * DFF; w.ldt = DFF; return w; }
}
__device__ __forceinline__ void tr_load(const WItem& w, f32x4 (&v)[8], float (&sc)[8], int lane) {
    const int kr = lane >> 3, c4 = (lane & 7) * 4;
#pragma unroll
    for (int i = 0; i < 8; ++i) { v[i] = __builtin_nontemporal_load((const GAS f32x4*)(w.W + (size_t)(w.k0 + 8 * i + kr) * w.ldw + w.scol0 + c4)); sc[i] = w.scale ? w.scale[w.k0 + 8 * i + kr] * w.smul : 1.0f; }
}
__device__ __forceinline__ void tr_load_data(const WItem& w, f32x4 (&v)[8], int lane) {
    const int kr = lane >> 3, c4 = (lane & 7) * 4;
#pragma unroll
    for (int i = 0; i < 8; ++i) v[i] = __builtin_nontemporal_load((const GAS f32x4*)(w.W + (size_t)(w.k0 + 8 * i + kr) * w.ldw + w.scol0 + c4));
}
__device__ __forceinline__ void tr_load_scale(const WItem& w, float (&sc)[8], int lane) {
    const int kr = lane >> 3;
#pragma unroll
    for (int i = 0; i < 8; ++i) sc[i] = w.scale ? w.scale[w.k0 + 8 * i + kr] * w.smul : 1.0f;
}
__device__ __forceinline__ void tr_store(const WItem& w, const f32x4 (&v)[8], const float (&sc)[8], LAS float* scr, int lane) {
    const int kr = lane >> 3, c4 = (lane & 7) * 4;
#pragma unroll
    for (int i = 0; i < 8; ++i) { LAS float* d = scr + (8 * i + kr) * 33 + c4; d[0] = v[i].x * sc[i]; d[1] = v[i].y * sc[i]; d[2] = v[i].z * sc[i]; d[3] = v[i].w * sc[i]; }
    LDS_WAIT(); asm volatile("" ::: "memory");
    const int c = lane & 7;
#pragma unroll
    for (int j = 0; j < 4; ++j) { const int n = (lane >> 3) + 8 * j; const LAS float* s = scr + (8 * c) * 33 + n;
        v4u o; o.x = pk2(s[0 * 33], s[1 * 33]); o.y = pk2(s[2 * 33], s[3 * 33]); o.z = pk2(s[4 * 33], s[5 * 33]); o.w = pk2(s[6 * 33], s[7 * 33]);
        *(GAS v4u*)(w.WT + (size_t)n * w.ldt + w.k0 + 8 * c) = o; }
    LDS_WAIT(); asm volatile("" ::: "memory");
}
__device__ __forceinline__ int wjob_chunks(int l) { return ((l + 1 < DEPTH) ? wcv::NITEMS : wcv::NREST) / 32; }
__device__ __forceinline__ WItem wjob_item(const DArgs& A, int l, int j) { return (j < wcv::NREST) ? weight_item(A, l, wcv::I1 + j) : weight_item(A, l + 1, j - wcv::NREST); }
__device__ __forceinline__ void wjob_chunk(const DArgs& A, int l, int chunk, LAS unsigned char* lds, int wave, int lane) {
    LAS float* scr = (LAS float*)(lds + wave * 8448);
    const int j0 = chunk * 32 + wave;
    const WItem wa = wjob_item(A, l, j0), wb = wjob_item(A, l, j0 + 8), wc = wjob_item(A, l, j0 + 16), wd = wjob_item(A, l, j0 + 24);
    f32x4 va[8], vb[8], vc[8], vd[8]; float sa[8], sb[8];
    tr_load_data(wa, va, lane); tr_load_scale(wa, sa, lane); tr_load_data(wb, vb, lane); tr_load_data(wc, vc, lane); tr_load_data(wd, vd, lane);
    asm volatile("" ::: "memory");
    tr_load_scale(wb, sb, lane); tr_store(wa, va, sa, scr, lane);
    tr_load_scale(wc, sa, lane); tr_store(wb, vb, sb, scr, lane);
    tr_load_scale(wd, sb, lane); tr_store(wc, vc, sa, scr, lane);
    tr_store(wd, vd, sb, scr, lane);
}
__device__ __forceinline__ void phase_weights(const DArgs& A, int l, LAS unsigned char* lds, int gw, int NGW, int wave, int lane) {
    LAS float* scr = (LAS float*)(lds + wave * 8448);
    for (int it = gw; it < wcv::I1; it += NGW) { const WItem w = weight_item(A, l, it); f32x4 v[8]; float sc[8]; tr_load(w, v, sc, lane); tr_store(w, v, sc, scr, lane); }
}

__device__ __forceinline__ void phase_xprep(const DArgs& A, int gw, int NGW, int lane) {
    const float* x = inp(A, 0); bf16* XB = (bf16*)(wsp(A) + WS_HB); float* SSQ = (float*)(wsp(A) + WS_SSQ);
    for (int row = gw; row < MTOK; row += NGW) {
        const GAS f32x4* xr = (const GAS f32x4*)(x + (size_t)row * DM) + lane;
        f32x4 v[8]; float ss = 0.f;
#pragma unroll
        for (int j = 0; j < 8; ++j) { v[j] = xr[64 * j]; ss += (v[j].x * v[j].x + v[j].y * v[j].y) + (v[j].z * v[j].z + v[j].w * v[j].w); }
        ss = wave_sum(ss);
        GAS unsigned long long* o8 = (GAS unsigned long long*)(XB + (size_t)row * DM) + lane;
#pragma unroll
        for (int j = 0; j < 8; ++j) o8[64 * j] = (unsigned long long)pk2(v[j].x, v[j].y) | ((unsigned long long)pk2(v[j].z, v[j].w) << 32);
        if (lane < 32) SSQ[(size_t)row * 32 + lane] = (lane == 0) ? ss : 0.f;
    }
}
__device__ __forceinline__ void phase_gates(const DArgs& A, int l, LAS unsigned char* lds, int gw, int NGW, int tid, int lane) {
    typedef short bf16x8 __attribute__((ext_vector_type(8)));
    const bf16* XB = (const bf16*)(wsp(A) + WS_HB); const float* SSQ = (const float*)(wsp(A) + WS_SSQ); float* G = (float*)(wsp(A) + WS_G);
    LAS bf16* WgL = (LAS bf16*)lds;
    { const float* w_in = inp(A, 2) + (size_t)l * DM * N_IN; const float* attn_nw = inp(A, 1) + (size_t)l * DM;
      for (int idx = tid; idx < 16 * DM; idx += NTHREADS) { const int k = idx >> 4, g = idx & 15; WgL[g * 2056 + k] = (bf16)f2bf(attn_nw[k] * w_in[(size_t)k * N_IN + SRC_GATE + g]); } }
    __syncthreads();
    const int fr = lane & 15, fq = lane >> 4;
    float bias[4];
#pragma unroll
    for (int i = 0; i < 4; ++i) { const int g = 4 * fq + i; bias[i] = (g < 8) ? inp(A, 5)[l * NHEAD + g] : inp(A, 6)[l * NHEAD + g - 8]; }
    for (int blk = gw; blk < MTOK / 16; blk += NGW) {
        const int row = blk * 16 + fr;
        const GAS bf16x8* xp = (const GAS bf16x8*)(XB + (size_t)row * DM + 8 * fq);
        const LAS bf16x8* wp = (const LAS bf16x8*)(WgL + fr * 2056 + 8 * fq);
        f32x4 acc = {0.f, 0.f, 0.f, 0.f};
#pragma unroll 16
        for (int ks = 0; ks < 64; ++ks) acc = __builtin_amdgcn_mfma_f32_16x16x32_bf16(wp[4 * ks], xp[4 * ks], acc, 0, 0, 0);
        const GAS f32x4* sp = (const GAS f32x4*)(SSQ + (size_t)row * 32); f32x4 t = sp[0];
#pragma unroll
        for (int j = 1; j < 8; ++j) t += sp[j];
        const float r = __builtin_amdgcn_rsqf(((t.x + t.y) + (t.z + t.w)) * (1.0f / DM) + EPS);
        f32x4 o;
#pragma unroll
        for (int i = 0; i < 4; ++i) { const float pre = acc[i] * r + bias[i]; o[i] = (fq < 2) ? pre : (fminf(pre, 0.f) - __logf(1.0f + __expf(-fabsf(pre)))); }
        *(GAS f32x4*)(G + (size_t)row * 16 + 4 * fq) = o;
    }
}

typedef unsigned u32x4 __attribute__((ext_vector_type(4)));
typedef unsigned u32x2 __attribute__((ext_vector_type(2)));
namespace ml {
typedef short bf16x8 __attribute__((ext_vector_type(8)));
typedef float f32x16 __attribute__((ext_vector_type(16)));
constexpr int OFF_Q = 0, OFF_K = 17408, OFF_KT = 34816, OFF_VT = 53248, OFF_ST = 90112, OFF_SC = 99328, OFF_CW = 107520, OFF_HV = 0  ;
constexpr int AS = 0, MLo = 64, INTER = 128, EINV = 192, DS0 = 256, NQ = 384, NV = 448;
__device__ __forceinline__ int swz256(int row, int colB) { return row * 272 + colB; }
__device__ __forceinline__ int swz128(int row, int colB) { return row * 144 + colB; }
__device__ __forceinline__ unsigned pk(float lo, float hi) { return attn::cvtpk(lo, hi); }
template <int CTRL> __device__ __forceinline__ float dppf(float x) { return __builtin_bit_cast(float, __builtin_amdgcn_update_dpp(0, __builtin_bit_cast(int, x), CTRL, 0xf, 0xf, false)); }
__device__ __forceinline__ float scan_add(float x, int lane) {
    const int rl = lane & 15; float t;
    t = dppf<0x111>(x); if (rl >= 1) x += t;
    t = dppf<0x112>(x); if (rl >= 2) x += t;
    t = dppf<0x114>(x); if (rl >= 4) x += t;
    t = dppf<0x118>(x); if (rl >= 8) x += t;
    t = dppf<0x142>(x); if ((lane & 31) >= 16) x += t;
    t = dppf<0x143>(x); if (lane >= 32) x += t;
    return x;
}
__device__ __forceinline__ float scan_max(float x, int lane) {
    const int rl = lane & 15; float t;
    t = dppf<0x111>(x); if (rl >= 1) x = fmaxf(x, t);
    t = dppf<0x112>(x); if (rl >= 2) x = fmaxf(x, t);
    t = dppf<0x114>(x); if (rl >= 4) x = fmaxf(x, t);
    t = dppf<0x118>(x); if (rl >= 8) x = fmaxf(x, t);
    t = dppf<0x142>(x); if ((lane & 31) >= 16) x = fmaxf(x, t);
    t = dppf<0x143>(x); if (lane >= 32) x = fmaxf(x, t);
    return x;
}
}

__device__ __forceinline__ void ml_conv4(const u32x2 (&raw)[7], const LAS float* cwl, int c4, float sc, float (&o)[4][4], LAS unsigned char* dst, int rg) {
    using namespace ml;
    typedef float f32x2v __attribute__((ext_vector_type(2)));
    f32x2v wa[4], wb[4];
#pragma unroll
    for (int j = 0; j < 4; ++j) { const f32x4 w = *(const LAS f32x4*)(cwl + j * 128 + c4); wa[j] = (f32x2v){w.x, w.y}; wb[j] = (f32x2v){w.z, w.w}; }
    const f32x4 bs = *(const LAS f32x4*)(cwl + 4 * 128 + c4);
    f32x2v xa[7], xb[7];
#pragma unroll
    for (int i = 0; i < 7; ++i) { xa[i] = (f32x2v){wlo(raw[i].x), whi(raw[i].x)}; xb[i] = (f32x2v){wlo(raw[i].y), whi(raw[i].y)}; }
#pragma unroll
    for (int i = 0; i < 4; ++i) {
        f32x2v a = {bs.x, bs.y}, b = {bs.z, bs.w};
#pragma unroll
        for (int j = 0; j < 4; ++j) { a = __builtin_elementwise_fma(wa[j], xa[i + j], a); b = __builtin_elementwise_fma(wb[j], xb[i + j], b); }
        o[i][0] = a.x; o[i][1] = a.y; o[i][2] = b.x; o[i][3] = b.y;
#pragma unroll
        for (int e = 0; e < 4; ++e) o[i][e] = o[i][e] * sigm(o[i][e]) * sc;
        u32x2 w; w.x = pk(o[i][0], o[i][1]); w.y = pk(o[i][2], o[i][3]);
        *(LAS u32x2*)(dst + swz256(4 * rg + i, 2 * c4)) = w;
    }
}
__device__ __forceinline__ void phase_mlstm_chunk(const DArgs& A, int l, int bh, LAS unsigned char* L, int tid) {
    using namespace ml;
#define ML_BAR() do { asm volatile("s_waitcnt lgkmcnt(0)" ::: "memory"); __builtin_amdgcn_s_barrier(); asm volatile("" ::: "memory"); } while (0)
    const int lane = tid & 63, wv = __builtin_amdgcn_readfirstlane(tid >> 6), c = lane & 31, hi = lane >> 5;
    const int b = bh >> 3, h = bh & 7;
#define ML_RD(dst, base, off) asm volatile("ds_read_b128 %0, %1 offset:%2" : "=&v"(dst) : "v"(base), "i"(off) : "memory")
#define ML_W(n) do { asm volatile("s_waitcnt lgkmcnt(" #n ")" ::: "memory"); __builtin_amdgcn_sched_barrier(0); } while (0)
    const unsigned lbase = (unsigned)(uintptr_t)L;
    const bf16* P = (const bf16*)(wsp(A) + WS_P); const float* G = (const float*)(wsp(A) + WS_G); bf16* HMD = (bf16*)(wsp(A) + WS_HMD);
    LAS float* SC = (LAS float*)(L + OFF_SC);
    LAS float* CWL = (LAS float*)(L + OFF_CW);
    { unsigned z = 0u; asm volatile("" : "+v"(z));
      if (tid < 128) *(LAS u32x4*)(L + OFF_ST + swz128(tid >> 2, (4 + (tid & 3)) * 16)) = (u32x4){z, z, z, z}; }
    if (tid < 32) SC[DS0 + 64 + tid] = 0.f;
    if (tid < 256) SC[NV + tid] = 0.f;
    { const float* cw = inp(A, 3) + (size_t)l * 4 * DM; const float* cb = inp(A, 4) + (size_t)l * DM;
      for (int idx = tid; idx < 1280; idx += NTHREADS) { const int it = idx / 640, rem = idx - it * 640, j = rem >> 7, cc = rem & 127, chn = (it ? C_MK : C_MQ) + h * 128 + cc;
          CWL[idx] = (j < 4) ? cw[j * DM + chn] : cb[chn]; } }
    f32x16 Cacc[4];
#pragma unroll
    for (int dd = 0; dd < 4; ++dd)
#pragma unroll
        for (int r = 0; r < 16; ++r) Cacc[dd][r] = 0.f;
    float m_prev = 0.f;
    const size_t rowb = (size_t)b * SEQ;
    const int rg = tid >> 5, cg = tid & 31, c4 = 4 * cg;
    u32x2 rq[7], rk[7]; v4u vr[4]; float g_ig, g_lf;
    const int rgv = tid & 15, cgv = tid >> 4;
    const unsigned toq = (unsigned)((4 * rg) * NP + c4) * 2u, tov = (unsigned)((4 * rgv) * NP + 8 * cgv) * 2u, tog = (unsigned)lane * 64u;
    const unsigned tom = (unsigned)(tid >> 3) * (unsigned)(NP * 2) + (unsigned)(tid & 7) * 64u, toh = (unsigned)(tid >> 3) * (unsigned)(4 * DM) + (unsigned)(tid & 7) * 64u;
#define ML_LOAD_RAW(chx, CHK0) do { const size_t r0_ = rowb + (size_t)(chx) * 64; \
        const GAS char* gb_ = (const GAS char*)(G + r0_ * 16 + h); g_ig = *(const GAS float*)(gb_ + tog); g_lf = *(const GAS float*)(gb_ + tog + 32); \
        const GAS char* qb_ = (const GAS char*)(P + r0_ * NP + h * 128) - 3 * NP * 2;     \
        _Pragma("unroll") for (int i = 0; i < 7; ++i) { const bool ok = (CHK0) ? (4 * rg - 3 + i >= 0) : true; \
            rq[i] = ok ? *(const GAS u32x2*)(qb_ + (toq + (unsigned)(i * NP * 2))) : (u32x2){0u, 0u}; rk[i] = ok ? *(const GAS u32x2*)(qb_ + (toq + (unsigned)(i * NP * 2)) + C_MK * 2) : (u32x2){0u, 0u}; } \
        } while (0)
#define ML_LOAD_V(chx) do { const GAS char* vb_ = (const GAS char*)(P + (rowb + (size_t)(chx) * 64) * NP + C_MV + h * 256); \
        _Pragma("unroll") for (int i = 0; i < 4; ++i) vr[i] = *(const GAS v4u*)(vb_ + (tov + (unsigned)(i * NP * 2))); } while (0)
    ML_LOAD_RAW(0, true); ML_LOAD_V(0);
    __syncthreads();
#pragma unroll 1
    for (int ch = 0; ch < SEQ / 64; ++ch) {
        const size_t row0 = rowb + (size_t)ch * 64;
        const float ig = g_ig, lf = g_lf;
        const float bc = scan_add(lf, lane);
        const float a = ig - bc; const float cm = scan_max(a, lane);
        const float Ml = fmaxf(m_prev, cm);
        const float M63 = __builtin_bit_cast(float, __builtin_amdgcn_readlane(__builtin_bit_cast(int, Ml), 63)), b63 = __builtin_bit_cast(float, __builtin_amdgcn_readlane(__builtin_bit_cast(int, bc), 63));
        const float wgt = __expf(a - M63), decay = __expf(m_prev - M63);
        if (wv == 0) { SC[AS + lane] = a; SC[MLo + lane] = Ml; SC[INTER + lane] = __expf(m_prev - Ml); SC[EINV + lane] = __expf(-(bc + Ml)); }
        const int wi_ = __builtin_bit_cast(int, wgt); const float w0 = __builtin_bit_cast(float, __builtin_amdgcn_ds_bpermute(16 * rg, wi_)), w1 = __builtin_bit_cast(float, __builtin_amdgcn_ds_bpermute(16 * rg + 4, wi_)), w2 = __builtin_bit_cast(float, __builtin_amdgcn_ds_bpermute(16 * rg + 8, wi_)), w3 = __builtin_bit_cast(float, __builtin_amdgcn_ds_bpermute(16 * rg + 12, wi_));
        { float o[4][4]; ml_conv4(rq, CWL, c4, 1.0f, o, L + OFF_Q, rg); }
        { float o[4][4]; ml_conv4(rk, CWL + 640, c4, 0.08838834764831845f, o, L + OFF_K, rg);
#pragma unroll
          for (int e = 0; e < 4; ++e) { u32x2 w; w.x = pk(o[0][e] * w0, o[1][e] * w1); w.y = pk(o[2][e] * w2, o[3][e] * w3);
              *(LAS u32x2*)(L + OFF_KT + swz128(c4 + e, 8 * rg)) = w; } }
        {
            const unsigned vw[4][4] = {{vr[0].x, vr[0].y, vr[0].z, vr[0].w}, {vr[1].x, vr[1].y, vr[1].z, vr[1].w}, {vr[2].x, vr[2].y, vr[2].z, vr[2].w}, {vr[3].x, vr[3].y, vr[3].z, vr[3].w}};
#pragma unroll
            for (int e = 0; e < 8; ++e) { const int k = e >> 1; u32x2 w;
                if (e & 1) { w.x = (vw[0][k] >> 16) | (vw[1][k] & 0xffff0000u); w.y = (vw[2][k] >> 16) | (vw[3][k] & 0xffff0000u); }
                else       { w.x = (vw[0][k] & 0xffffu) | (vw[1][k] << 16);     w.y = (vw[2][k] & 0xffffu) | (vw[3][k] << 16); }
                *(LAS u32x2*)(L + OFF_VT + swz128(8 * cgv + e, 8 * rgv)) = w; }
        }
        ML_BAR();
        { const int chn = (ch + 1 < SEQ / 64) ? ch + 1 : 1; ML_LOAD_RAW(chn, false); }
        if (wv < 3) {
            const int lh = (wv == 0) ? 0 : 1, sh = (wv == 2) ? 1 : 0;
            f32x16 acc;
#pragma unroll
            for (int r = 0; r < 16; ++r) acc[r] = 0.f;
            {
                const unsigned skb = lbase + OFF_K + swz256(32 * sh + c, 16 * hi), sqb = lbase + OFF_Q + swz256(32 * lh + c, 16 * hi);
                bf16x8 X0, X1, X2, X3, Y0, Y1, Y2, Y3;
#define S_RD4(S, g) do { ML_RD(S##0, skb, 64 * (g)); ML_RD(S##1, sqb, 64 * (g)); ML_RD(S##2, skb, 64 * (g) + 32); ML_RD(S##3, sqb, 64 * (g) + 32); } while (0)
#define S_MM(S) do { acc = __builtin_amdgcn_mfma_f32_32x32x16_bf16(S##0, S##1, acc, 0, 0, 0); acc = __builtin_amdgcn_mfma_f32_32x32x16_bf16(S##2, S##3, acc, 0, 0, 0); } while (0)
                S_RD4(X, 0);
                S_RD4(Y, 1); ML_W(4); S_MM(X);
                S_RD4(X, 2); ML_W(4); S_MM(Y);
                S_RD4(Y, 3); ML_W(4); S_MM(X);
                ML_W(0); S_MM(Y);
#undef S_RD4
#undef S_MM
            }
            const int tl = 32 * lh + c; const float Mt = SC[MLo + tl]; float rs = 0.f;
#pragma unroll
            for (int g = 0; g < 4; ++g) {
                const int s0 = 32 * sh + 8 * g + 4 * hi; const f32x4 as4 = *(const LAS f32x4*)(SC + AS + s0);
                float vv[4];
#pragma unroll
                for (int e = 0; e < 4; ++e) { const float ev = (s0 + e <= tl) ? __expf(as4[e] - Mt) : 0.f; vv[e] = acc[4 * g + e] * ev; rs += vv[e]; }
                u32x2 w; w.x = pk(vv[0], vv[1]); w.y = pk(vv[2], vv[3]);
                *(LAS u32x2*)(L + OFF_ST + swz128(tl, 2 * s0)) = w;
            }
            { auto t = __builtin_amdgcn_permlane32_swap(__float_as_uint(rs), __float_as_uint(rs), false, false); rs = __uint_as_float(t[0]) + __uint_as_float(t[1]); }
            if (hi == 0) SC[DS0 + sh * 64 + tl] = rs;
        } else if (wv >= 4) {
            const LAS float* nold = SC + NV + (ch & 1) * 128; LAS float* nnew = SC + NV + ((ch + 1) & 1) * 128;
            { const int row = 16 * (wv - 4) + (lane >> 2), qd = lane & 3; float acc = 0.f;
#pragma unroll
              for (int ck = 0; ck < 4; ++ck) { const v4u q8 = *(const LAS v4u*)(L + OFF_Q + swz256(row, (4 * qd + ck) * 16)); const f32x4 n0 = *(const LAS f32x4*)(nold + 32 * qd + 8 * ck), n1 = *(const LAS f32x4*)(nold + 32 * qd + 8 * ck + 4);
                  acc += (wlo(q8.x) * n0.x + whi(q8.x) * n0.y) + (wlo(q8.y) * n0.z + whi(q8.y) * n0.w) + (wlo(q8.z) * n1.x + whi(q8.z) * n1.y) + (wlo(q8.w) * n1.z + whi(q8.w) * n1.w); }
              acc = sum4_f(acc);
              if (qd == 0) SC[NQ + row] = acc; }
            { const int d = 32 * (wv - 4) + (lane >> 1), sh2 = lane & 1; float sm = 0.f;
#pragma unroll
              for (int ck = 0; ck < 4; ++ck) { const v4u k8 = *(const LAS v4u*)(L + OFF_KT + swz128(d, (4 * sh2 + ck) * 16)); sm += ((wlo(k8.x) + whi(k8.x)) + (wlo(k8.y) + whi(k8.y))) + ((wlo(k8.z) + whi(k8.z)) + (wlo(k8.w) + whi(k8.w))); }
              sm += xor1_f(sm);
              if (sh2 == 0) nnew[d] = decay * nold[d] + sm; }
        }
        f32x16 oi[2];
#pragma unroll
        for (int lh = 0; lh < 2; ++lh)
#pragma unroll
            for (int r = 0; r < 16; ++r) oi[lh][r] = 0.f;
        {
            const unsigned qb0 = lbase + OFF_Q + swz256(c, 8 * hi), qb1 = qb0 + 32 * 272;
            bf16x8 X0, X1, X2, X3, Y0, Y1, Y2, Y3;
#define I_RD(dst, base, dd, j2) asm volatile("ds_read2_b64 %0, %1 offset0:%2 offset1:%3" : "=&v"(dst) : "v"(base), "i"(8 * (dd) + 4 * (j2)), "i"(8 * (dd) + 4 * (j2) + 2) : "memory")
#define I_RD4(S, dd) do { I_RD(S##0, qb0, dd, 0); I_RD(S##1, qb1, dd, 0); I_RD(S##2, qb0, dd, 1); I_RD(S##3, qb1, dd, 1); } while (0)
#define I_MM(S, dd) do { \
            const bf16x8 a0_ = attn::pack8((f32x4){Cacc[dd][0], Cacc[dd][1], Cacc[dd][2], Cacc[dd][3]}, (f32x4){Cacc[dd][4], Cacc[dd][5], Cacc[dd][6], Cacc[dd][7]}); \
            const bf16x8 a1_ = attn::pack8((f32x4){Cacc[dd][8], Cacc[dd][9], Cacc[dd][10], Cacc[dd][11]}, (f32x4){Cacc[dd][12], Cacc[dd][13], Cacc[dd][14], Cacc[dd][15]}); \
            oi[0] = __builtin_amdgcn_mfma_f32_32x32x16_bf16(a0_, S##0, oi[0], 0, 0, 0); oi[1] = __builtin_amdgcn_mfma_f32_32x32x16_bf16(a0_, S##1, oi[1], 0, 0, 0); \
            oi[0] = __builtin_amdgcn_mfma_f32_32x32x16_bf16(a1_, S##2, oi[0], 0, 0, 0); oi[1] = __builtin_amdgcn_mfma_f32_32x32x16_bf16(a1_, S##3, oi[1], 0, 0, 0); } while (0)
            I_RD4(X, 0);
            I_RD4(Y, 1); ML_W(4); I_MM(X, 0);
            I_RD4(X, 2); ML_W(4); I_MM(Y, 1);
            I_RD4(Y, 3); ML_W(4); I_MM(X, 2);
            ML_W(0); I_MM(Y, 3);
#undef I_RD
#undef I_RD4
#undef I_MM
        }
        ML_BAR();
        bf16x8 vf[4], sf[4];
        const unsigned stb = lbase + OFF_ST + swz128(c, 16 * hi);
        { const unsigned hvb = lbase + OFF_VT + swz128(32 * wv + c, 16 * hi);
          ML_RD(vf[0], hvb, 0); ML_RD(vf[1], hvb, 32); ML_RD(vf[2], hvb, 64); ML_RD(vf[3], hvb, 96);
          ML_RD(sf[0], stb, 0); ML_RD(sf[1], stb, 32); ML_RD(sf[2], stb, 64); ML_RD(sf[3], stb, 96); }
#pragma unroll
        for (int lh = 0; lh < 2; ++lh) {
            const int tl = 32 * lh + c; const float it = SC[INTER + tl];
            const float den = (SC[DS0 + tl] + SC[DS0 + 64 + tl]) + it * SC[NQ + tl];
            const float inv = __builtin_amdgcn_rcpf(fmaxf(fabsf(den), SC[EINV + tl]));
            f32x16 t = oi[lh] * it;
            ML_W(0);
#pragma unroll
            for (int ks = 0; ks < 4; ++ks) t = __builtin_amdgcn_mfma_f32_32x32x16_bf16(vf[ks], sf[ks], t, 0, 0, 0);
            if (lh == 0) { __builtin_amdgcn_sched_barrier(0); ML_RD(sf[0], stb, 4608); ML_RD(sf[1], stb, 4608 + 32); ML_RD(sf[2], stb, 4608 + 64); ML_RD(sf[3], stb, 4608 + 96); }
#pragma unroll
            for (int g = 0; g < 4; ++g) { u32x2 w;
                w.x = pk(t[4 * g] * inv, t[4 * g + 1] * inv); w.y = pk(t[4 * g + 2] * inv, t[4 * g + 3] * inv);
                *(LAS u32x2*)(L + OFF_HV + tl * 528 + (32 * wv + 8 * g + 4 * hi) * 2) = w; }
        }
        asm volatile("" ::: "memory");
        v4u mo[4];
#pragma unroll
        for (int q = 0; q < 4; ++q) mo[q] = *(const GAS v4u*)((const GAS char*)(P + row0 * NP + C_MO + h * 256) + tom + q * 16);
        ML_BAR();
        {
            const int rl = tid >> 3, sg = tid & 7;
            v4u hq[4]; float ss = 0.f;
#pragma unroll
            for (int q = 0; q < 4; ++q) { hq[q] = *(const LAS v4u*)(L + OFF_HV + rl * 528 + sg * 64 + q * 16);
                const unsigned hw[4] = {hq[q].x, hq[q].y, hq[q].z, hq[q].w};
#pragma unroll
                for (int k = 0; k < 4; ++k) { const float x0 = wlo(hw[k]), x1 = whi(hw[k]); ss += x0 * x0 + x1 * x1; } }
            ss = sum8_f(ss);
            const float rn = __builtin_amdgcn_rsqf(ss * (1.0f / 256.0f) + EPS);
            GAS char* orow = (GAS char*)(HMD + row0 * (2 * DM) + h * 256) + toh;
#pragma unroll
            for (int q = 0; q < 4; ++q) { const unsigned hw[4] = {hq[q].x, hq[q].y, hq[q].z, hq[q].w}; const unsigned mw[4] = {mo[q].x, mo[q].y, mo[q].z, mo[q].w}; unsigned ow[4];
#pragma unroll
                for (int k = 0; k < 4; ++k) ow[k] = pk(wlo(hw[k]) * rn * wlo(mw[k]), whi(hw[k]) * rn * whi(mw[k]));
                *(GAS v4u*)(orow + q * 16) = (v4u){ow[0], ow[1], ow[2], ow[3]}; }
        }
        asm volatile("" ::: "memory");
        { const int chn = (ch + 1 < SEQ / 64) ? ch + 1 : ch; ML_LOAD_V(chn); }
        {
            const unsigned hvb = lbase + OFF_VT + swz128(32 * wv + c, 16 * hi), ktb = lbase + OFF_KT + swz128(c, 16 * hi);
            bf16x8 vf2[4], X0, X1, X2, X3, Y0, Y1, Y2, Y3;
#define U_RD4(S, dd) do { ML_RD(S##0, ktb, (dd) * 4608); ML_RD(S##1, ktb, (dd) * 4608 + 32); ML_RD(S##2, ktb, (dd) * 4608 + 64); ML_RD(S##3, ktb, (dd) * 4608 + 96); } while (0)
#define U_MM(S, dd) do { Cacc[dd] = Cacc[dd] * decay; \
            Cacc[dd] = __builtin_amdgcn_mfma_f32_32x32x16_bf16(S##0, vf2[0], Cacc[dd], 0, 0, 0); Cacc[dd] = __builtin_amdgcn_mfma_f32_32x32x16_bf16(S##1, vf2[1], Cacc[dd], 0, 0, 0); \
            Cacc[dd] = __builtin_amdgcn_mfma_f32_32x32x16_bf16(S##2, vf2[2], Cacc[dd], 0, 0, 0); Cacc[dd] = __builtin_amdgcn_mfma_f32_32x32x16_bf16(S##3, vf2[3], Cacc[dd], 0, 0, 0); } while (0)
            ML_RD(vf2[0], hvb, 0); ML_RD(vf2[1], hvb, 32); ML_RD(vf2[2], hvb, 64); ML_RD(vf2[3], hvb, 96);
            U_RD4(X, 0); U_RD4(Y, 1);
            ML_W(4); U_MM(X, 0);
            U_RD4(X, 2); ML_W(4); U_MM(Y, 1);
            U_RD4(Y, 3); ML_W(4); U_MM(X, 2);
            ML_W(0); U_MM(Y, 3);
#undef U_RD4
#undef U_MM
        }
        m_prev = b63 + M63;
        ML_BAR();
    }
#undef ML_LOAD_RAW
#undef ML_LOAD_V
#undef ML_BAR
#undef ML_RD
#undef ML_W
}

typedef attn::BlockRef<attn::bf16, attn::bf16> ABlock;
constexpr int ATT_ITEMS = NBATCH * NHEAD * 4 * 16;
__device__ __forceinline__ ABlock attn_ref(const DArgs& A, int item) {
    const int vh = item & 127, qb = 15 - (item >> 7), comp = vh & 1, half = (vh >> 1) & 1, h = (vh >> 2) & 7, b = vh >> 5;
    const attn::bf16* P = (const attn::bf16*)(wsp(A) + WS_P);
    attn::bf16* O = (attn::bf16*)(wsp(A) + (comp ? WS_HD2 : WS_HD1));
    ABlock r;
    const size_t row0 = (size_t)b * SEQ;
    r.Q = P + (row0 + (size_t)qb * 256) * NP + C_DQ + h * 256 + comp * 128;
    r.K = P + row0 * NP + C_DK + h * 256 + comp * 128;
    r.V = P + row0 * NP + C_DV + h * 256 + half * 128;
    r.O = O + (row0 + (size_t)qb * 256) * DM + h * 256 + half * 128;
    r.P0 = qb * 256;
    return r;
}
__device__ __forceinline__ void phase_attn(const DArgs& A, char* lds, gu32* ctr, volatile LAS unsigned* qs, int tid) {
    if (tid == 0) { qs[0] = __hip_atomic_fetch_add(ctr, 1u, RLX_AGENT); qs[1] = __hip_atomic_fetch_add(ctr, 1u, RLX_AGENT); }
    __syncthreads();
    int Lc = (int)qs[0], Ln = (int)qs[1];
    if (Lc >= ATT_ITEMS) return;
    ABlock cur = attn_ref(A, Lc);
    attn::Seam<attn::bf16> S;
    attn::causal_swa_prime<attn::bf16, attn::bf16>(cur, SEQ, lds, S);
    for (;;) {
        const bool has_next = Ln < ATT_ITEMS;
        const ABlock nxt = has_next ? attn_ref(A, Ln) : cur;
        attn::causal_swa_block<attn::bf16, attn::bf16>(cur, nxt, SEQ, SEQ, lds, S);
        if (!has_next) break;
        cur = nxt;
        if (tid == 0) qs[0] = __hip_atomic_fetch_add(ctr, 1u, RLX_AGENT);
        __syncthreads();
        Ln = (int)qs[0];
    }
}

namespace at2 {
constexpr int OFF_K = 0  , OFF_V = 32768  , OFF_P = 98304  , OFF_AL = 131072  , OFF_FLG = 132096  , OFF_LI = 132160  , ITEMS = NBATCH * NHEAD * 2 * 32;
}
__device__ __forceinline__ void phase_attn2(const DArgs& A, int l, char* lds, gu32* ctr, volatile LAS unsigned* qs, int tid) {
    typedef attn::bf16 abf; typedef attn::bf16x8 bf16x8; typedef attn::f32x16 f32x16;
    const int wid = __builtin_amdgcn_readfirstlane(tid >> 6), lane = tid & 63, r32 = lane & 31, hi = lane >> 5, pair = wid & 3;
    const bool scorer = wid < 4;
    const int sr = tid >> 4, sc = (tid & 15) * 8, kws = sr * 256 + ((sc * 2) ^ ((sr & 7) << 4))  , vst0 = attn::v_st(sr, sc);
    const unsigned toff = (unsigned)(sr * attn::LDP + sc) * 2u;
    char* K_lds = lds + at2::OFF_K; char* V_lds = lds + at2::OFF_V; char* P_lds = lds + at2::OFF_P;
    float* AL = (float*)(lds + at2::OFF_AL); unsigned* FLG = (unsigned*)(lds + at2::OFF_FLG); float* LI = (float*)(lds + at2::OFF_LI);
    const int vb0 = (int)(uintptr_t)V_lds + attn::v_rd_base(lane);
#define A2_BAR() do { asm volatile("s_waitcnt lgkmcnt(0)" ::: "memory"); __builtin_amdgcn_s_barrier(); asm volatile("" ::: "memory"); } while (0)
    const unsigned xq0 = xb_xcc_id() & 7u;
#define A2_FETCH() do { if (tid == 0) { unsigned r_ = 0xFFFFFFFFu; for (unsigned k_ = qs[1]; k_ < 8u; ++k_) { const unsigned q_ = (xq0 + k_) & 7u; \
            const unsigned i_ = __hip_atomic_fetch_add(ctr + 64 * q_, 1u, RLX_AGENT); if (i_ < 128u) { r_ = q_ * 256u + 2u * i_; qs[1] = k_; break; } qs[1] = k_ + 1u; } qs[0] = r_; \
            qs[2] = __hip_atomic_fetch_add(ctr + 32, 1u, RLX_AGENT); } } while (0)
    if (tid == 0) qs[1] = 0u;
    A2_FETCH();
    if (wid == 0) {
        const float* lq1 = inp(A, 8) + l * 128; const float* lk1 = inp(A, 9) + l * 128; const float* lq2 = inp(A, 10) + l * 128; const float* lk2 = inp(A, 11) + l * 128;
        const float s1 = wave_sum(lq1[lane] * lk1[lane] + lq1[lane + 64] * lk1[lane + 64]), s2 = wave_sum(lq2[lane] * lk2[lane] + lq2[lane + 64] * lk2[lane + 64]);
        float e1 = __expf(s1), e2 = __expf(s2), li = lam_init_of(l);
        asm volatile("" : "+v"(e1)); asm volatile("" : "+v"(e2)); asm volatile("" : "+v"(li));
        if (lane == 0) qs[4] = __float_as_uint((e1 - e2) + li); }
    __syncthreads();
    unsigned item = qs[0], cid = qs[2];
    const unsigned NCH = (unsigned)wjob_chunks(l);
    for (;;) {
        if (cid < NCH) { wjob_chunk(A, l, (int)cid, A.L, wid, lane); __syncthreads(); }
        if (item == 0xFFFFFFFFu) break;
        const int xq = (int)(item >> 8), ii = (int)(item & 255u), qb = 31 - (ii >> 3), hh = ii & 7, bh = xq * 4 + (hh >> 1), comp = hh & 1, h = bh & 7, b = bh >> 3;
        const int P0 = qb * 128, NT = qb * 2 + 2;
        const abf* Pm = (const abf*)(wsp(A) + WS_P); const size_t row0 = (size_t)b * SEQ;
        const abf* Qp = Pm + (row0 + P0) * NP + C_DQ + h * 256 + comp * 128;
        const abf* Kp = Pm + row0 * NP + C_DK + h * 256 + comp * 128;
        const abf* Vp = Pm + row0 * NP + C_DV + h * 256;
        abf* Op = (abf*)(wsp(A) + (comp ? WS_HD2 : WS_HD1)) + (row0 + P0) * DM + h * 256;
        const int s16 = (tid & 255) >> 4;
        const unsigned toff16 = (unsigned)(s16 * attn::LDP + sc) * 2u;
        const int qlo = P0 + pair * 32, qm = qlo + r32 - 4 * hi;
        if (scorer) {
            const int vst16 = attn::v_st(s16, sc);
            bf16x8 svA[8], svB[8];
#define SV_LOAD(sv, tv_) do { const int tc_ = ((tv_) < NT) ? (tv_) : NT - 1; const abf* vb_ = Vp + (size_t)tc_ * 64 * attn::LDP; \
                _Pragma("unroll") for (int j = 0; j < 4; ++j) { sv[j] = attn::load8<abf>((const abf*)((const char*)(vb_ + 16 * j * attn::LDP) + toff16)); sv[4 + j] = attn::load8<abf>((const abf*)((const char*)(vb_ + 16 * j * attn::LDP + 128) + toff16)); } } while (0)
#define SV_WRITE(sv, tv_) do { char* vd_ = V_lds + ((tv_) & 1) * 32768;     \
                _Pragma("unroll") for (int j = 0; j < 4; ++j) { *(bf16x8*)(vd_ + vst16 + j * 4096) = sv[j]; *(bf16x8*)(vd_ + 16384 + vst16 + j * 4096) = sv[4 + j]; } } while (0)
            SV_LOAD(svA, 0); SV_LOAD(svB, 1);
            bf16x8 qr[8];
#pragma unroll
            for (int d0 = 0; d0 < 8; ++d0) qr[d0] = attn::load8<abf>((const abf*)((const char*)(Qp + (size_t)(pair * 32) * attn::LDP + d0 * 16) + (unsigned)(r32 * attn::LDP + hi * 8) * 2u));
            float m_reg = -1e30f, l_reg = 0.f;
            A2_BAR();
            f32x16 pA0, pA1, pB0, pB1;
            const int kq0 = (int)(uintptr_t)K_lds, kx = (r32 & 7) << 4, ka0 = kq0 + r32 * 256 + ((hi * 16) ^ kx), ka1 = kq0 + r32 * 256 + ((32 + hi * 16) ^ kx), ka2 = kq0 + r32 * 256 + ((64 + hi * 16) ^ kx), ka3 = kq0 + r32 * 256 + ((96 + hi * 16) ^ kx);
            attn::qkt2<0>(pA0, pA1, ka0, ka1, ka2, ka3, qr);
            A2_BAR();
#define A2_SCORE(t_, C0, C1, N0, N1, KBN, SVS) do { const int tt_ = (t_), pb = tt_ & 1; \
                SV_WRITE(SVS, tt_); \
                SV_LOAD(SVS, tt_ + 2); \
                __builtin_amdgcn_sched_barrier(0); \
                if (tt_ + 1 < NT) attn::qkt2<KBN>(N0, N1, ka0, ka1, ka2, ka3, qr); \
                { float mn, alpha; bf16x8 pa0, pa1, pa2, pa3; const int kb_ = tt_ * 64; \
                  if (kb_ + 63 > qlo) attn::mask_tile(C0, C1, qm - kb_, (unsigned)SEQ);     \
                  attn::partialSM(C0, C1, m_reg, mn, alpha); \
                  attn::finishSM(C0, C1, alpha, l_reg, pa0, pa1, pa2, pa3); \
                  char* pd = P_lds + pb * 16384 + pair * 4096 + lane * 16; \
                  *(bf16x8*)(pd) = pa0; *(bf16x8*)(pd + 1024) = pa1; *(bf16x8*)(pd + 2048) = pa2; *(bf16x8*)(pd + 3072) = pa3; \
                  if (hi == 0) AL[(pb * 4 + pair) * 32 + r32] = alpha; \
                  const bool any = __any(alpha < 1.f); \
                  if (lane == 0) FLG[pb * 4 + pair] = any ? 1u : 0u; } \
                A2_BAR();                                            \
                } while (0)
            for (int t = 0; t < NT; t += 2) {
                A2_SCORE(t, pA0, pA1, pB0, pB1, 1, svA);
                A2_SCORE(t + 1, pB0, pB1, pA0, pA1, 0, svB);
            }
#undef A2_SCORE
#undef SV_LOAD
#undef SV_WRITE
            A2_BAR();
            if (hi == 0) LI[pair * 32 + r32] = l_reg;
            A2_BAR();
        } else {
            const int kws16 = s16 * 256 + ((sc * 2) ^ ((s16 & 7) << 4));
            bf16x8 sk[4];
#define VK_LOAD(tk_) do { if ((tk_) < NT) { const abf* kb_ = Kp + (size_t)(tk_) * 64 * attn::LDP; \
                _Pragma("unroll") for (int j = 0; j < 4; ++j) sk[j] = attn::load8<abf>((const abf*)((const char*)(kb_ + 16 * j * attn::LDP) + toff16)); } } while (0)
#define VK_WRITE(tk_) do { if ((tk_) < NT) { char* kd_ = K_lds + ((tk_) & 1) * 16384; \
                _Pragma("unroll") for (int j = 0; j < 4; ++j) *(bf16x8*)(kd_ + kws16 + j * 4096) = sk[j]; } } while (0)
            VK_LOAD(0); VK_WRITE(0);
            VK_LOAD(1); VK_WRITE(1);
            VK_LOAD(2);
            f32x16 o[8];
#pragma unroll
            for (int d = 0; d < 8; ++d)
#pragma unroll
                for (int r = 0; r < 16; ++r) o[d][r] = 0.f;
            A2_BAR();
            A2_BAR();
            for (int t = 0; t <= NT; ++t) {
                VK_WRITE(t + 2);
                VK_LOAD(t + 3);
                if (t >= 1) {
                    const int pp = (t - 1) & 1;
                    const unsigned flv = FLG[pp * 4 + pair];
                    const char* ps = P_lds + pp * 16384 + pair * 4096 + lane * 16;
                    const bf16x8 pa0 = *(const bf16x8*)(ps), pa1 = *(const bf16x8*)(ps + 1024), pa2 = *(const bf16x8*)(ps + 2048), pa3 = *(const bf16x8*)(ps + 3072);
                    const int vbb = vb0 + pp * 32768;
                    typedef attn::s16x4 s16x4;
#define A2_TRRD(dst, off) asm volatile("ds_read_b64_tr_b16 %0, %1 offset:%2" : "=&v"(dst) : "v"(vbb), "i"(off) : "memory")
#define A2_RD(S, g) do { constexpr int b_ = ((g) >> 2) * 16384 + ((g) & 3) * 512;     \
                        A2_TRRD(S##l0, b_); A2_TRRD(S##h0, b_ + 2048); A2_TRRD(S##l1, b_ + 4096); A2_TRRD(S##h1, b_ + 6144); A2_TRRD(S##l2, b_ + 8192); A2_TRRD(S##h2, b_ + 10240); A2_TRRD(S##l3, b_ + 12288); A2_TRRD(S##h3, b_ + 14336); } while (0)
#define A2_MM(S, g) do {     \
                        o[g] = __builtin_amdgcn_mfma_f32_32x32x16_bf16((bf16x8){S##l0[0], S##l0[1], S##l0[2], S##l0[3], S##h0[0], S##h0[1], S##h0[2], S##h0[3]}, pa0, o[g], 0, 0, 0); \
                        o[g] = __builtin_amdgcn_mfma_f32_32x32x16_bf16((bf16x8){S##l1[0], S##l1[1], S##l1[2], S##l1[3], S##h1[0], S##h1[1], S##h1[2], S##h1[3]}, pa1, o[g], 0, 0, 0); \
                        o[g] = __builtin_amdgcn_mfma_f32_32x32x16_bf16((bf16x8){S##l2[0], S##l2[1], S##l2[2], S##l2[3], S##h2[0], S##h2[1], S##h2[2], S##h2[3]}, pa2, o[g], 0, 0, 0); \
                        o[g] = __builtin_amdgcn_mfma_f32_32x32x16_bf16((bf16x8){S##l3[0], S##l3[1], S##l3[2], S##l3[3], S##h3[0], S##h3[1], S##h3[2], S##h3[3]}, pa3, o[g], 0, 0, 0); } while (0)
#define A2_W8() do { asm volatile("s_waitcnt lgkmcnt(8)" ::: "memory"); __builtin_amdgcn_sched_barrier(0); } while (0)
#define A2_W0() do { asm volatile("s_waitcnt lgkmcnt(0)" ::: "memory"); __builtin_amdgcn_sched_barrier(0); } while (0)
                    s16x4 Xl0, Xl1, Xl2, Xl3, Xh0, Xh1, Xh2, Xh3, Yl0, Yl1, Yl2, Yl3, Yh0, Yh1, Yh2, Yh3;
                    A2_RD(X, 0);
                    A2_RD(Y, 1);
#define A2_SC(g) do { if (fl != 0u) { const float al = AL[(pp * 4 + pair) * 32 + r32]; o[g] = o[g] * al; } } while (0)
                    const unsigned fl = __builtin_amdgcn_readfirstlane(flv);
                    A2_W8(); A2_SC(0); A2_MM(X, 0);
                    A2_RD(X, 2); A2_W8(); A2_SC(1); A2_MM(Y, 1);
                    A2_RD(Y, 3); A2_W8(); A2_SC(2); A2_MM(X, 2);
                    A2_RD(X, 4); A2_W8(); A2_SC(3); A2_MM(Y, 3);
                    A2_RD(Y, 5); A2_W8(); A2_SC(4); A2_MM(X, 4);
                    A2_RD(X, 6); A2_W8(); A2_SC(5); A2_MM(Y, 5);
                    A2_RD(Y, 7); A2_W8(); A2_SC(6); A2_MM(X, 6);
                    A2_W0(); A2_SC(7); A2_MM(Y, 7);
#undef A2_SC
#undef A2_TRRD
#undef A2_RD
#undef A2_MM
#undef A2_W8
#undef A2_W0
                }
                A2_BAR();
            }
            A2_BAR();
            const float rl = __builtin_amdgcn_rcpf(LI[pair * 32 + r32]);
            char* Ow = (char*)(Op + (size_t)(pair * 32 + r32) * DM) + (hi ? 16 : 0);
#pragma unroll
            for (int g = 0; g < 8; ++g) {
                const f32x16 t = o[g] * rl;
#pragma unroll
                for (int kp = 0; kp < 2; ++kp) {
                    unsigned ax = attn::cvtpk(t[8 * kp], t[8 * kp + 1]), ay = attn::cvtpk(t[8 * kp + 2], t[8 * kp + 3]);
                    unsigned bx = attn::cvtpk(t[8 * kp + 4], t[8 * kp + 5]), by = attn::cvtpk(t[8 * kp + 6], t[8 * kp + 7]);
                    { auto r = __builtin_amdgcn_permlane32_swap(ax, bx, false, false); ax = r[0]; bx = r[1]; }
                    { auto r = __builtin_amdgcn_permlane32_swap(ay, by, false, false); ay = r[0]; by = r[1]; }
                    *(attn::u32x4*)(Ow + g * 64 + kp * 32) = (attn::u32x4){ax, ay, bx, by};
                }
            }
        }
        const unsigned itE = (unsigned)__builtin_amdgcn_readfirstlane((int)qs[0]);
        if (itE & 1u) {
            asm volatile("s_waitcnt vmcnt(0)" ::: "memory");
            __syncthreads();
            const float lam = __uint_as_float(qs[4]);
            const int it2 = (int)itE;
            const int xq2 = it2 >> 8, ii2 = it2 & 255, qb2 = 31 - (ii2 >> 3), bh2 = xq2 * 4 + ((ii2 & 7) >> 1), h2 = bh2 & 7, b2 = bh2 >> 3;
            const size_t rw = (size_t)b2 * SEQ + (size_t)(qb2 * 128 + 16 * wid + (lane >> 4));
            const bf16* H1 = (const bf16*)(wsp(A) + WS_HD1) + rw * DM + h2 * 256 + 16 * (lane & 15);
            const bf16* H2 = (const bf16*)(wsp(A) + WS_HD2) + rw * DM + h2 * 256 + 16 * (lane & 15);
            bf16* HO = (bf16*)(wsp(A) + WS_HMD) + rw * (2 * DM) + DM + h2 * 256 + 16 * (lane & 15);
            v4u a[4][2], c[4][2];
#pragma unroll
            for (int i = 0; i < 4; ++i) { a[i][0] = *(const GAS v4u*)(H1 + (size_t)(4 * i) * DM); a[i][1] = *(const GAS v4u*)(H1 + (size_t)(4 * i) * DM + 8);
                                          c[i][0] = *(const GAS v4u*)(H2 + (size_t)(4 * i) * DM); c[i][1] = *(const GAS v4u*)(H2 + (size_t)(4 * i) * DM + 8); }
#pragma unroll
            for (int i = 0; i < 4; ++i) {
                float d[16]; float ss = 0.f;
#pragma unroll
                for (int q = 0; q < 2; ++q) { const unsigned aw[4] = {a[i][q].x, a[i][q].y, a[i][q].z, a[i][q].w}, cw[4] = {c[i][q].x, c[i][q].y, c[i][q].z, c[i][q].w};
#pragma unroll
                    for (int k = 0; k < 4; ++k) { const float x0 = wlo(aw[k]) - wlo(cw[k]) * lam, x1 = whi(aw[k]) - whi(cw[k]) * lam; d[8 * q + 2 * k] = x0; d[8 * q + 2 * k + 1] = x1; ss += x0 * x0 + x1 * x1; } }
                ss = sum16_f(ss);
                const float rd = __builtin_amdgcn_rsqf(ss * (1.0f / 256.0f) + EPS);
#pragma unroll
                for (int q = 0; q < 2; ++q)
                    *(GAS v4u*)(HO + (size_t)(4 * i) * (2 * DM) + 8 * q) = (v4u){pk2(d[8 * q] * rd, d[8 * q + 1] * rd), pk2(d[8 * q + 2] * rd, d[8 * q + 3] * rd), pk2(d[8 * q + 4] * rd, d[8 * q + 5] * rd), pk2(d[8 * q + 6] * rd, d[8 * q + 7] * rd)};
            }
        }
        __syncthreads();
        if (tid == 0 && (itE & 1u) == 0u) { qs[0] = itE | 1u; qs[2] = 0xFFFFFFFFu; }
        if (itE & 1u) A2_FETCH();
        __syncthreads();
        item = qs[0]; cid = qs[2];
    }
    for (;;) {
        __syncthreads();
        if (tid == 0) qs[2] = __hip_atomic_fetch_add(ctr + 32, 1u, RLX_AGENT);
        __syncthreads();
        cid = qs[2];
        if (cid >= NCH) break;
        wjob_chunk(A, l, (int)cid, A.L, wid, lane);
    }
#undef A2_FETCH
#undef VK_LOAD
#undef VK_WRITE
#undef A2_BAR
}

__device__ __forceinline__ void phase_combine(const DArgs& A, int l, int gw, int NGW, int lane) {
    const bf16* HD1 = (const bf16*)(wsp(A) + WS_HD1); const bf16* HD2 = (const bf16*)(wsp(A) + WS_HD2);
    bf16* HMD = (bf16*)(wsp(A) + WS_HMD);
    const float* lq1 = inp(A, 8) + l * 128; const float* lk1 = inp(A, 9) + l * 128; const float* lq2 = inp(A, 10) + l * 128; const float* lk2 = inp(A, 11) + l * 128;
    const float s1 = wave_sum(lq1[lane] * lk1[lane] + lq1[lane + 64] * lk1[lane + 64]), s2 = wave_sum(lq2[lane] * lk2[lane] + lq2[lane + 64] * lk2[lane + 64]);
    const float lam = __expf(s1) - __expf(s2) + lam_init_of(l);
    for (int row = gw; row < MTOK; row += NGW) {
        unsigned long long d1[8], d2[8];
#pragma unroll
        for (int j = 0; j < 8; ++j) { const size_t o = (size_t)row * DM + 256 * j + 4 * lane; d1[j] = *(const GAS unsigned long long*)(HD1 + o); d2[j] = *(const GAS unsigned long long*)(HD2 + o); }
#pragma unroll
        for (int j = 0; j < 8; ++j) {
            const unsigned a0 = (unsigned)d1[j], a1 = (unsigned)(d1[j] >> 32), b0 = (unsigned)d2[j], b1 = (unsigned)(d2[j] >> 32);
            const f32x4 d = {wlo(a0) - wlo(b0) * lam, whi(a0) - whi(b0) * lam, wlo(a1) - wlo(b1) * lam, whi(a1) - whi(b1) * lam};
            const float ssd = wave_sum((d.x * d.x + d.y * d.y) + (d.z * d.z + d.w * d.w));
            const float rd = __builtin_amdgcn_rsqf(ssd * (1.0f / 256.0f) + EPS);
            *(GAS unsigned long long*)(HMD + (size_t)row * (2 * DM) + DM + 256 * j + 4 * lane) = (unsigned long long)pk2(d.x * rd, d.y * rd) | ((unsigned long long)pk2(d.z * rd, d.w * rd) << 32);
        }
    }
}

__device__ __forceinline__ void phase_final(const DArgs& A, int gw, int NGW, int lane) {
    const bf16* XB = (const bf16*)(wsp(A) + WS_HB); const float* SSQ = (const float*)(wsp(A) + WS_SSQ); const float* fw = inp(A, 20);
    f32x4 w[8];
#pragma unroll
    for (int j = 0; j < 8; ++j) w[j] = ((const GAS f32x4*)fw)[lane + 64 * j];
    for (int row = gw; row < MTOK; row += NGW) {
        const GAS unsigned long long* xr = (const GAS unsigned long long*)(XB + (size_t)row * DM) + lane;
        unsigned long long v[8];
#pragma unroll
        for (int j = 0; j < 8; ++j) v[j] = xr[64 * j];
        const float sp = (lane < 32) ? SSQ[(size_t)row * 32 + lane] : 0.f;
        const float r = __builtin_amdgcn_rsqf(wave_sum(sp) * (1.0f / DM) + EPS);
        GAS f32x4* o = (GAS f32x4*)(outp(A) + (size_t)row * DM) + lane;
#pragma unroll
        for (int j = 0; j < 8; ++j) { const unsigned a0 = (unsigned)v[j], a1 = (unsigned)(v[j] >> 32); o[64 * j] = (f32x4){wlo(a0), whi(a0), wlo(a1), whi(a1)} * r * w[j]; }
    }
}

__global__ void __launch_bounds__(NTHREADS, 2) hybrid_fwd(Args KA) {
    extern __shared__ __attribute__((aligned(16))) unsigned char lds[];
    LAS unsigned char* L = (LAS unsigned char*)lds;
    DArgs A; A.L = L; A.l_lo = KA.l_lo; A.l_hi = KA.l_hi; A.ph_lo = KA.ph_lo; A.ph_hi = KA.ph_hi; A.do_final = KA.do_final; A.use_bar = KA.use_bar; A.sub = KA.sub; A.qoff = KA.qoff;
    volatile LAS unsigned* MISC = (volatile LAS unsigned*)(L + MISC_OFF);
#define tid (T_)
#define lane (T_ & 63)
#define wave (__builtin_amdgcn_readfirstlane(T_ >> 6))
#define G (GX_)
#define bx (BX_)
#define gw (bx * NWAVES + wave)
#define NGW (G * NWAVES)
#define gtid (bx * NTHREADS + tid)
#define NGT (G * NTHREADS)
    const int T_ = tidx(), BX_ = sopq((int)blockIdx.x), GX_ = sopq((int)gridDim.x);
    gu32* ctl = (gu32*)(KA.ws + WS_CTL);
    for (int u = tid; u < (LDS_BYTES - LDSCTL_OFF) / 4; u += NTHREADS) ((LAS unsigned*)(L + LDSCTL_OFF))[u] = 0u;
    __syncthreads();
    if (tid == 0) {
#pragma unroll
        for (int i = 0; i < 21; ++i) ((LAS unsigned long long*)(L + PTR_OFF))[i] = (unsigned long long)KA.in[i];
    }
    if (tid == 21) ((LAS unsigned long long*)(L + PTR_OFF))[21] = (unsigned long long)KA.out;
    if (tid == 22) ((LAS unsigned long long*)(L + PTR_OFF))[22] = (unsigned long long)KA.ws;
    __syncthreads();
    XcdBarrier bar; bar.bar = (unsigned*)(ctl + CW_BAR); bar.x = 0; bar.st = nullptr;
    if (A.use_bar) bar = xcd_barrier_post((unsigned*)(ctl + CW_BAR), MISC + 8);
#define IN(k) (sopq(A.ph_lo) <= (k) && (k) < sopq(A.ph_hi))
#define SEAM() do { if (A.use_bar) xcd_barrier(bar); else __syncthreads(); } while (0)
#define WSB(off) ((bf16*)(wsp(A) + (off)))
#define WSF(off) ((float*)(wsp(A) + (off)))
#pragma unroll 1
    for (int l = A.l_lo; l < A.l_hi; ++l) {
        if (l == 0 && IN(10)) { const int T_ = tidx(), BX_ = sopq((int)blockIdx.x), GX_ = sopq((int)gridDim.x); phase_xprep(A, gw, NGW, lane); SEAM(); }
        if (IN(0)) { const int T_ = tidx(), BX_ = sopq((int)blockIdx.x), GX_ = sopq((int)gridDim.x);
            if (l == 0) phase_weights(A, l, L, gw, NGW, wave, lane);
            __syncthreads();
            phase_gates(A, l, L, gw, NGW, tid, lane);
            SEAM();
        }
        if (IN(1)) { const int T_ = tidx(), BX_ = sopq((int)blockIdx.x), GX_ = sopq((int)gridDim.x);
            pg8::Gemm g{WSB(WS_HB), WSB(WS_W1), MTOK, NP, DM, DM}; pg8::StaticOrder S; S.init(MTOK, NP, G, bx);
            pg8::Unit u0; u0.pm = 0; u0.pn = 0; u0.kh = 0; (void)S.next(0, u0);
            if (tid < 256) { const GAS f32x4* sp = (const GAS f32x4*)(WSF(WS_SSQ) + (size_t)(u0.pm * 256 + tid) * 32); f32x4 t = sp[0];
#pragma unroll
                for (int j = 1; j < 8; ++j) t += sp[j];
                ((LAS float*)(L + RT_OFF))[tid] = __builtin_amdgcn_rsqf(((t.x + t.y) + (t.z + t.w)) * (1.0f / DM) + EPS); }
            __syncthreads();
            pg8::EpiStoreBf16R E{WSB(WS_P), NP, WSF(WS_SSQ), (LAS float*)(L + RT_OFF), u0.pm, C_MO / 256, (C_MO + NHEAD * 256) / 256};
            pg8::gemm_phase<pg8::EpiStoreBf16R, pg8::StaticOrder, true, true>(L, g, S, E);
            SEAM();
        }
        if (IN(3)) { const int T_ = tidx(), BX_ = sopq((int)blockIdx.x), GX_ = sopq((int)gridDim.x);
            if (bx < MLSTM_WGS && (sopq(A.sub) & 1)) phase_mlstm_chunk(A, l, bx, L, tid);
            __syncthreads();
            if (sopq(A.sub) & 2) phase_attn2(A, l, (char*)lds, ctl + CW_Q + 512 * (sopq(A.qoff) + l), MISC + 16, tid);
            SEAM();
        }
        if (IN(5)) { const int T_ = tidx(), BX_ = sopq((int)blockIdx.x), GX_ = sopq((int)gridDim.x);
            pg8::Gemm g{WSB(WS_HMD), WSB(WS_W2), MTOK, DM, DM, 2 * DM}; pg8::HalfKOrder S; S.init(MTOK, DM, G, bx);
            pg8::EpiGated E{WSB(WS_P), NP, C_GM, C_GD, WSB(WS_Y), DM};
            pg8::gemm_phase<pg8::EpiGated, pg8::HalfKOrder, true, true>(L, g, S, E);
            SEAM();
        }
        if (IN(6)) { const int T_ = tidx(), BX_ = sopq((int)blockIdx.x), GX_ = sopq((int)gridDim.x);
            pg8::Gemm g{WSB(WS_Y), WSB(WS_W3), MTOK, DM, DM, DM}; pg8::StaticOrder S; S.init(MTOK, DM, G, bx);
            pg8::EpiResidB E{WSB(WS_HB), WSF(WS_SSQ), nullptr, DM};
            pg8::gemm_phase<pg8::EpiResidB, pg8::StaticOrder, true, true>(L, g, S, E);
            SEAM();
        }
        if (IN(8)) { const int T_ = tidx(), BX_ = sopq((int)blockIdx.x), GX_ = sopq((int)gridDim.x);
            pg8::Gemm g{WSB(WS_HB), WSB(WS_W4), MTOK, 2 * DFF, DM, DM}; pg8::StaticOrder S; S.init(MTOK, 2 * DFF, G, bx);
            pg8::Unit u0; u0.pm = 0; u0.pn = 0; u0.kh = 0; (void)S.next(0, u0);
            if (tid < 256) { const GAS f32x4* sp = (const GAS f32x4*)(WSF(WS_SSQ) + (size_t)(u0.pm * 256 + tid) * 32); f32x4 t = sp[0];
#pragma unroll
                for (int j = 1; j < 8; ++j) t += sp[j];
                ((LAS float*)(L + RT_OFF))[tid] = __builtin_amdgcn_rsqf(((t.x + t.y) + (t.z + t.w)) * (1.0f / DM) + EPS); }
            __syncthreads();
            pg8::EpiSwigluR E{WSB(WS_P), DFF, WSF(WS_SSQ), (LAS float*)(L + RT_OFF), u0.pm};
            pg8::gemm_phase<pg8::EpiSwigluR, pg8::StaticOrder, true, true>(L, g, S, E);
            SEAM();
        }
        if (IN(9)) { const int T_ = tidx(), BX_ = sopq((int)blockIdx.x), GX_ = sopq((int)gridDim.x);
            pg8::Gemm g{WSB(WS_P), WSB(WS_W5), MTOK, DM, DFF, DFF}; pg8::StaticOrder S; S.init(MTOK, DM, G, bx);
            pg8::EpiResidB E{WSB(WS_HB), WSF(WS_SSQ), nullptr, DM};
            pg8::gemm_phase<pg8::EpiResidB, pg8::StaticOrder, true, true>(L, g, S, E);
            SEAM();
        }
    }
    if (A.do_final) { const int T_ = tidx(), BX_ = sopq((int)blockIdx.x), GX_ = sopq((int)gridDim.x); phase_final(A, gw, NGW, lane); }
#undef IN
#undef SEAM
#undef WSB
#undef WSF
#undef tid
#undef lane
#undef wave
#undef G
#undef bx
#undef gw
#undef NGW
#undef gtid
#undef NGT
}

#ifndef MK_ONE_LAUNCH
#define MK_ONE_LAUNCH 1
#endif
extern "C" void kernel_launch(void* const* d_in, const int* in_sizes, int n_in, void* d_out, int out_size, void* d_ws, size_t ws_size, hipStream_t stream) {
    static int grid = 0;
    if (grid == 0) {
        if (n_in != 21 || in_sizes[0] != MTOK * DM || out_size != MTOK * DM || ws_size < WS_END) {
            fprintf(stderr, "kernel_launch: shape mismatch (n_in %d, in0 %d, out %d, ws %zu); nothing launched\n", n_in, n_in > 0 ? in_sizes[0] : -1, out_size, ws_size); grid = -1; return; }
        int dev = 0, cus = 0, per_cu = 0;
        if (hipGetDevice(&dev) != hipSuccess || hipDeviceGetAttribute(&cus, hipDeviceAttributeMultiprocessorCount, dev) != hipSuccess) { grid = -1; return; }
        if (hipFuncSetAttribute((const void*)hybrid_fwd, hipFuncAttributeMaxDynamicSharedMemorySize, LDS_BYTES) != hipSuccess) { fprintf(stderr, "kernel_launch: hipFuncSetAttribute failed\n"); grid = -1; return; }
        if (hipOccupancyMaxActiveBlocksPerMultiprocessor(&per_cu, (const void*)hybrid_fwd, NTHREADS, LDS_BYTES) != hipSuccess || per_cu < 1)
            fprintf(stderr, "kernel_launch: note: occupancy query reports %d workgroups per CU\n", per_cu);
        (void)hipGetLastError();
        grid = cus;
    }
    if (grid < 0) return;
    if (hipMemsetAsync((char*)d_ws + WS_CTL, 0, CTL_ZERO_BYTES, stream) != hipSuccess) { fprintf(stderr, "kernel_launch: memset failed\n"); return; }
    Args a{};
    for (int i = 0; i < 21; ++i) a.in[i] = (const float*)d_in[i];
    a.out = (float*)d_out; a.ws = (unsigned char*)d_ws; a.sub = 3; a.qoff = 0;
#if MK_ONE_LAUNCH
    a.l_lo = 0; a.l_hi = DEPTH; a.ph_lo = 0; a.ph_hi = 11; a.do_final = 1; a.use_bar = 1;
    hipLaunchKernelGGL(hybrid_fwd, dim3(grid), dim3(NTHREADS), LDS_BYTES, stream, a);
#else
#ifndef PROBE_DUP
#define PROBE_DUP 0x0
#endif
#ifndef PROBE_SUB
#define PROBE_SUB 1
#endif
    for (int l = 0; l < DEPTH; ++l)
        for (int pi = 0; pi < 11; ++pi) {
            const int ph = (pi == 0) ? 10 : pi - 1;
            if (ph == 2 || ph == 4 || ph == 7 || (ph == 10 && l != 0)) continue;
            a.l_lo = l; a.l_hi = l + 1; a.ph_lo = ph; a.ph_hi = ph + 1; a.do_final = 0; a.use_bar = 0;
            for (int rep = 0; rep < (((PROBE_DUP >> ph) & 1) ? 2 : 1); ++rep) {
                a.sub = (rep == 1 && ph == 3) ? PROBE_SUB : 3; a.qoff = (rep == 1) ? 4 : 0;
                hipLaunchKernelGGL(hybrid_fwd, dim3(grid), dim3(NTHREADS), LDS_BYTES, stream, a); }
        }
    a.l_lo = 0; a.l_hi = 0; a.ph_lo = 0; a.ph_hi = 0; a.do_final = 1; a.use_bar = 0;
    hipLaunchKernelGGL(hybrid_fwd, dim3(grid), dim3(NTHREADS), LDS_BYTES, stream, a);
#endif
    const hipError_t le = hipPeekAtLastError();
    if (le != hipSuccess) fprintf(stderr, "kernel_launch: launch failed: %s\n", hipGetErrorName(le));
}
```

```cpp
#include <hip/hip_runtime.h>
#include <hip/hip_bf16.h>
#include <cstdio>
#include <cstdint>
__device__ __forceinline__ int tidx() { int t = (int)threadIdx.x; asm volatile("" : "+v"(t)); return t; }
__device__ __forceinline__ int sopq(int v) { asm volatile("" : "+s"(v)); return v; }
namespace pg8 {
#define PG8_LAS __attribute__((address_space(3)))
typedef unsigned short bf16_t;
typedef short bf16x8 __attribute__((ext_vector_type(8)));
typedef float f32x4 __attribute__((ext_vector_type(4)));
typedef unsigned u32x4 __attribute__((ext_vector_type(4)));
constexpr int BM = 256, BK = 64, HALF = 128, HTB = HALF * BK * 2  , STAGE_BYTES = 8 * HTB, NXCD = 8, WGM = 8;

__host__ __device__ __forceinline__ int lds_byte(int r, int c) { const int st = (r >> 4) * 2 + (c >> 5), rr = r & 15, cc = c & 31, ob = rr * 64 + cc * 2; return st * 1024 + (ob ^ (((ob >> 9) & 1) << 5)); }
__host__ __device__ __forceinline__ void stage_rc(int b, int& R, int& C) { const int st = b / 1024, sb = b % 1024, swz = sb ^ (((sb >> 9) & 1) << 5); R = (st >> 1) * 16 + swz / 64; C = (st & 1) * 32 + (swz % 64) / 2; }
__host__ __device__ __forceinline__ int perm32(int rho) { const int n = rho >> 4, i = rho & 15; return 8 * (i >> 2) + 4 * n + (i & 3); }

struct Unit { int pm, pn, kh; };
struct Gemm { const bf16_t* A; const bf16_t* Bt; int M, N, K, ld; };

struct StaticOrder {
    int nM, nN, nwg, G, c;
    __host__ __device__ void init(int M, int N, int G_, int c_) { nM = M / BM; nN = N / BM; nwg = nM * nN; G = G_; c = c_; }
    __host__ __device__ bool next(int i, Unit& u) const {
        const long L = (long)i * G + c; if (L >= nwg) return false;
        int wgid = (int)L; { const int q = nwg / NXCD, r = nwg % NXCD, xcd = wgid % NXCD, off = wgid / NXCD; wgid = (xcd < r ? xcd * (q + 1) : r * (q + 1) + (xcd - r) * q) + off; }
        const int nig = WGM * nN, gid = wgid / nig, fm = gid * WGM, gsz = (nM - fm) < WGM ? (nM - fm) : WGM;
        u.pm = fm + ((wgid % nig) % gsz); u.pn = (wgid % nig) / gsz; u.kh = 0; return true;
    }
    __device__ __forceinline__ void a_ready(const Unit&) const {}
    __device__ __forceinline__ void done(const Unit&) const {}
};
struct HalfKOrder : StaticOrder {
    __host__ __device__ bool next(int i, Unit& u) const { const bool ok = StaticOrder::next(i >> 1, u); u.kh = i & 1; return ok; }
};

__device__ __forceinline__ unsigned cvt_pk_bf16(float lo, float hi) { unsigned r; asm volatile("v_cvt_pk_bf16_f32 %0, %1, %2" : "=v"(r) : "v"(lo), "v"(hi)); return r; }
typedef float f32x2 __attribute__((ext_vector_type(2)));
typedef unsigned u32x2 __attribute__((ext_vector_type(2)));
__device__ __forceinline__ float bf_lo(unsigned w) { return __uint_as_float(w << 16); }
__device__ __forceinline__ float bf_hi(unsigned w) { return __uint_as_float(w & 0xffff0000u); }
__device__ __forceinline__ float sigmoidf_(float x) { return __builtin_amdgcn_rcpf(1.0f + __expf(-x)); }

struct EpiStoreBf16 {
    static constexpr bool PERM = true, AFTER_DRAIN = false, MID = false;
    bf16_t* O; int ldc;
    __device__ __forceinline__ void operator()(f32x4 (&acc)[2][2][4][2], const Unit& u, int wr, int wc, int fr, int fq) const {
        const int row0 = u.pm * BM + wr * 64 + fr, col0 = u.pn * BM + wc * 32 + 8 * fq;
#pragma unroll
        for (int ai = 0; ai < 2; ++ai)
#pragma unroll
            for (int m = 0; m < 4; ++m) { bf16_t* rowp = O + (size_t)(row0 + ai * HALF + m * 16) * ldc + col0;
#pragma unroll
                for (int bj = 0; bj < 2; ++bj) { const f32x4 v0 = acc[ai][bj][m][0], v1 = acc[ai][bj][m][1];
                    u32x4 w; w.x = cvt_pk_bf16(v0[0], v0[1]); w.y = cvt_pk_bf16(v0[2], v0[3]); w.z = cvt_pk_bf16(v1[0], v1[1]); w.w = cvt_pk_bf16(v1[2], v1[3]);
                    *(u32x4*)(rowp + bj * HALF) = w; } }
    }
};
constexpr int NSSQ = 32;
__device__ __forceinline__ float xrow16_sum(float x) {
    auto s = __builtin_amdgcn_permlane16_swap(__float_as_uint(x), __float_as_uint(x), false, false);
    x = __uint_as_float(s[0]) + __uint_as_float(s[1]);
    auto t = __builtin_amdgcn_permlane32_swap(__float_as_uint(x), __float_as_uint(x), false, false);
    return __uint_as_float(t[0]) + __uint_as_float(t[1]);
}
__device__ __forceinline__ void load_rscale(const float* ssq, PG8_LAS float* rt, const Unit& u, int wr, int fr, int fq, float (&r)[2][4]) {
    const int lane = fr + 16 * fq;
#pragma unroll
    for (int ai = 0; ai < 2; ++ai) { const f32x4* p = (const f32x4*)(ssq + (size_t)(u.pm * BM + ai * HALF + wr * 64 + lane) * NSSQ); f32x4 t = p[0];
#pragma unroll
        for (int j = 1; j < 8; ++j) t += p[j];
        rt[ai * 64 + lane] = __builtin_amdgcn_rsqf(((t[0] + t[1]) + (t[2] + t[3])) * (1.0f / 2048.0f) + 1e-6f); }
    asm volatile("s_waitcnt lgkmcnt(0)" ::: "memory");
#pragma unroll
    for (int ai = 0; ai < 2; ++ai)
#pragma unroll
        for (int m = 0; m < 4; ++m) r[ai][m] = rt[ai * 64 + m * 16 + fr];
    asm volatile("" ::: "memory");
}
__device__ __forceinline__ void get_rscale(const float* ssq, PG8_LAS float* rtb, int pm0, const Unit& u, int wr, int wc, int fr, int fq, float (&r)[2][4]) {
    if (u.pm == pm0) {
#pragma unroll
        for (int ai = 0; ai < 2; ++ai)
#pragma unroll
            for (int m = 0; m < 4; ++m) r[ai][m] = rtb[ai * HALF + wr * 64 + m * 16 + fr];
    } else load_rscale(ssq, rtb + 256 + (wr * 4 + wc) * 128, u, wr, fr, fq, r);
}
struct EpiStoreBf16R {
    static constexpr bool PERM = true, AFTER_DRAIN = false, MID = false;
    bf16_t* O; int ldc; const float* ssq; PG8_LAS float* rtb; int pm0; int sg_lo, sg_hi;
    __device__ __forceinline__ void operator()(f32x4 (&acc)[2][2][4][2], const Unit& u, int wr, int wc, int fr, int fq) const {
        float r[2][4]; get_rscale(ssq, rtb, pm0, u, wr, wc, fr, fq, r);
        const int row0 = u.pm * BM + wr * 64 + fr, col0 = u.pn * BM + wc * 32 + 8 * fq;
        const bool sg = (u.pn >= sg_lo) && (u.pn < sg_hi);
#pragma unroll
        for (int ai = 0; ai < 2; ++ai)
#pragma unroll
            for (int m = 0; m < 4; ++m) { bf16_t* rowp = O + (size_t)(row0 + ai * HALF + m * 16) * ldc + col0; const float rr = r[ai][m];
#pragma unroll
                for (int bj = 0; bj < 2; ++bj) { f32x4 v0 = acc[ai][bj][m][0] * rr, v1 = acc[ai][bj][m][1] * rr;
                    if (sg) {
#pragma unroll
                        for (int e = 0; e < 4; ++e) { v0[e] = __builtin_amdgcn_rcpf(1.0f + __expf(-v0[e])); v1[e] = __builtin_amdgcn_rcpf(1.0f + __expf(-v1[e])); } }
                    u32x4 w; w.x = cvt_pk_bf16(v0[0], v0[1]); w.y = cvt_pk_bf16(v0[2], v0[3]); w.z = cvt_pk_bf16(v1[0], v1[1]); w.w = cvt_pk_bf16(v1[2], v1[3]);
                    *(u32x4*)(rowp + bj * HALF) = w; } }
    }
};
struct EpiResidStats {
    static constexpr bool PERM = false, AFTER_DRAIN = false, MID = false;
    const float* xin; float* xout; bf16_t* xb; float* ssq; int ldc;
    __device__ __forceinline__ void operator()(f32x4 (&acc)[2][2][4][2], const Unit& u, int wr, int wc, int fr, int fq) const {
        const int row0 = u.pm * BM + wr * 64 + fr, col0 = u.pn * BM + wc * 32 + 4 * fq;
#pragma unroll
        for (int ai = 0; ai < 2; ++ai)
#pragma unroll
            for (int m = 0; m < 4; ++m) { const int row = row0 + ai * HALF + m * 16; const size_t off = (size_t)row * ldc + col0; float sq = 0.f;
#pragma unroll
                for (int bj = 0; bj < 2; ++bj)
#pragma unroll
                    for (int n = 0; n < 2; ++n) { const size_t o2 = off + bj * HALF + n * 16; const f32x4 xv = *(const f32x4*)(xin + o2) + acc[ai][bj][m][n]; *(f32x4*)(xout + o2) = xv;
                        sq += (xv[0] * xv[0] + xv[1] * xv[1]) + (xv[2] * xv[2] + xv[3] * xv[3]);
                        u32x2 w; w.x = cvt_pk_bf16(xv[0], xv[1]); w.y = cvt_pk_bf16(xv[2], xv[3]); *(u32x2*)(xb + o2) = w; }
                sq = xrow16_sum(sq);
                if (fq == 0) ssq[(size_t)row * NSSQ + u.pn * 4 + wc] = sq; }
    }
};
struct EpiResidB {
    static constexpr bool PERM = true, AFTER_DRAIN = false, MID = false;
    bf16_t* xb; float* ssq; float* xf; int ldc;
    __device__ __forceinline__ void operator()(f32x4 (&acc)[2][2][4][2], const Unit& u, int wr, int wc, int fr, int fq) const {
        const int row0 = u.pm * BM + wr * 64 + fr, col0 = u.pn * BM + wc * 32 + 8 * fq;
#pragma unroll
        for (int ai = 0; ai < 2; ++ai)
#pragma unroll
            for (int m = 0; m < 4; ++m) { const int row = row0 + ai * HALF + m * 16; const size_t off = (size_t)row * ldc + col0; float sq = 0.f;
#pragma unroll
                for (int bj = 0; bj < 2; ++bj) { const u32x4 xi = *(const u32x4*)(xb + off + bj * HALF);
                    f32x4 v0 = acc[ai][bj][m][0], v1 = acc[ai][bj][m][1];
                    v0[0] += bf_lo(xi.x); v0[1] += bf_hi(xi.x); v0[2] += bf_lo(xi.y); v0[3] += bf_hi(xi.y); v1[0] += bf_lo(xi.z); v1[1] += bf_hi(xi.z); v1[2] += bf_lo(xi.w); v1[3] += bf_hi(xi.w);
                    sq += ((v0[0] * v0[0] + v0[1] * v0[1]) + (v0[2] * v0[2] + v0[3] * v0[3])) + ((v1[0] * v1[0] + v1[1] * v1[1]) + (v1[2] * v1[2] + v1[3] * v1[3]));
                    u32x4 w; w.x = cvt_pk_bf16(v0[0], v0[1]); w.y = cvt_pk_bf16(v0[2], v0[3]); w.z = cvt_pk_bf16(v1[0], v1[1]); w.w = cvt_pk_bf16(v1[2], v1[3]);
                    *(u32x4*)(xb + off + bj * HALF) = w;
                    if (xf) { *(f32x4*)(xf + off + bj * HALF) = v0; *(f32x4*)(xf + off + bj * HALF + 4) = v1; } }
                sq = xrow16_sum(sq);
                if (fq == 0) ssq[(size_t)row * NSSQ + u.pn * 4 + wc] = sq; }
    }
};
struct EpiResid {
    static constexpr bool PERM = false, AFTER_DRAIN = false, MID = false;
    const float* xin; float* xout; int ldc;
    __device__ __forceinline__ void operator()(f32x4 (&acc)[2][2][4][2], const Unit& u, int wr, int wc, int fr, int fq) const {
        const int row0 = u.pm * BM + wr * 64 + fr, col0 = u.pn * BM + wc * 32 + 4 * fq;
#pragma unroll
        for (int ai = 0; ai < 2; ++ai)
#pragma unroll
            for (int m = 0; m < 4; ++m) { const size_t off = (size_t)(row0 + ai * HALF + m * 16) * ldc + col0;
#pragma unroll
                for (int bj = 0; bj < 2; ++bj)
#pragma unroll
                    for (int n = 0; n < 2; ++n) { const size_t o2 = off + bj * HALF + n * 16; const f32x4 xv = *(const f32x4*)(xin + o2); *(f32x4*)(xout + o2) = xv + acc[ai][bj][m][n]; } }
    }
};
struct EpiSwiglu {
    static constexpr bool PERM = true, AFTER_DRAIN = false, MID = false;
    bf16_t* O; int ldc;
    __device__ __forceinline__ void operator()(f32x4 (&acc)[2][2][4][2], const Unit& u, int wr, int wc, int fr, int fq) const {
        const int row0 = u.pm * BM + wr * 64 + fr, col0 = u.pn * HALF + wc * 32 + 8 * fq;
#pragma unroll
        for (int ai = 0; ai < 2; ++ai)
#pragma unroll
            for (int m = 0; m < 4; ++m) { bf16_t* rowp = O + (size_t)(row0 + ai * HALF + m * 16) * ldc + col0;
                float r[8];
#pragma unroll
                for (int n = 0; n < 2; ++n)
#pragma unroll
                    for (int i = 0; i < 4; ++i) { const float g = acc[ai][0][m][n][i], up = acc[ai][1][m][n][i]; r[n * 4 + i] = g * sigmoidf_(g) * up; }
                u32x4 w; w.x = cvt_pk_bf16(r[0], r[1]); w.y = cvt_pk_bf16(r[2], r[3]); w.z = cvt_pk_bf16(r[4], r[5]); w.w = cvt_pk_bf16(r[6], r[7]);
                *(u32x4*)rowp = w; }
    }
};
struct EpiSwigluR {
    static constexpr bool PERM = true, AFTER_DRAIN = false, MID = false;
    bf16_t* O; int ldc; const float* ssq; PG8_LAS float* rtb; int pm0;
    __device__ __forceinline__ void operator()(f32x4 (&acc)[2][2][4][2], const Unit& u, int wr, int wc, int fr, int fq) const {
        float r[2][4]; get_rscale(ssq, rtb, pm0, u, wr, wc, fr, fq, r);
        const int row0 = u.pm * BM + wr * 64 + fr, col0 = u.pn * HALF + wc * 32 + 8 * fq;
#pragma unroll
        for (int ai = 0; ai < 2; ++ai)
#pragma unroll
            for (int m = 0; m < 4; ++m) { bf16_t* rowp = O + (size_t)(row0 + ai * HALF + m * 16) * ldc + col0; const float rr = r[ai][m];
                float o[8];
#pragma unroll
                for (int n = 0; n < 2; ++n)
#pragma unroll
                    for (int i = 0; i < 4; ++i) { const float g = acc[ai][0][m][n][i] * rr, up = acc[ai][1][m][n][i] * rr; o[n * 4 + i] = g * sigmoidf_(g) * up; }
                u32x4 w; w.x = cvt_pk_bf16(o[0], o[1]); w.y = cvt_pk_bf16(o[2], o[3]); w.z = cvt_pk_bf16(o[4], o[5]); w.w = cvt_pk_bf16(o[6], o[7]);
                *(u32x4*)rowp = w; }
    }
};
struct EpiGated {
    static constexpr bool PERM = true, AFTER_DRAIN = false, MID = true;
    const bf16_t* P; int ldp, cgm, cgd; bf16_t* O; int ldc;
    __device__ __forceinline__ static float cl(float x) { return fminf(fmaxf(x, -30.f), 30.f); }
    __device__ __forceinline__ void operator()(f32x4 (&acc)[2][2][4][2], const Unit& u, int wr, int wc, int fr, int fq) const { if (u.kh == 0) mid(acc, u, wr, wc, fr, fq); else fin(acc, u, wr, wc, fr, fq); }
    __device__ __forceinline__ void mid(f32x4 (&acc)[2][2][4][2], const Unit& u, int wr, int wc, int fr, int fq) const {
        const int row0 = u.pm * BM + wr * 64 + fr, col0 = u.pn * BM + wc * 32 + 8 * fq;
#pragma unroll
        for (int ai = 0; ai < 2; ++ai)
#pragma unroll
            for (int m = 0; m < 4; ++m) { const bf16_t* rowp = P + (size_t)(row0 + ai * HALF + m * 16) * ldp + col0;
#pragma unroll
                for (int bj = 0; bj < 2; ++bj) { const u32x4 a = *(const u32x4*)(rowp + cgm + bj * HALF), b = *(const u32x4*)(rowp + cgd + bj * HALF);
                    const unsigned aw[4] = {a.x, a.y, a.z, a.w}, bw[4] = {b.x, b.y, b.z, b.w};
#pragma unroll
                    for (int k = 0; k < 4; ++k) { const float gm0 = cl(bf_lo(aw[k])), gm1 = cl(bf_hi(aw[k])), gd0 = cl(bf_lo(bw[k])), gd1 = cl(bf_hi(bw[k]));
                        const float r0 = (1.0f + __expf(-gd0)) * __builtin_amdgcn_rcpf(1.0f + __expf(-gm0)), r1 = (1.0f + __expf(-gd1)) * __builtin_amdgcn_rcpf(1.0f + __expf(-gm1));
                        acc[ai][bj][m][k >> 1][(k & 1) * 2] *= r0; acc[ai][bj][m][k >> 1][(k & 1) * 2 + 1] *= r1; } }
                asm volatile("" ::: "memory"); }
    }
    __device__ __forceinline__ void fin(f32x4 (&acc)[2][2][4][2], const Unit& u, int wr, int wc, int fr, int fq) const {
        const int row0 = u.pm * BM + wr * 64 + fr, col0 = u.pn * BM + wc * 32 + 8 * fq;
#pragma unroll
        for (int ai = 0; ai < 2; ++ai)
#pragma unroll
            for (int m = 0; m < 4; ++m) { const size_t r = (size_t)(row0 + ai * HALF + m * 16); const bf16_t* gp = P + r * ldp + cgd + col0; bf16_t* rowp = O + r * ldc + col0;
#pragma unroll
                for (int bj = 0; bj < 2; ++bj) { const u32x4 b = *(const u32x4*)(gp + bj * HALF); const unsigned bw[4] = {b.x, b.y, b.z, b.w}; float o[8];
#pragma unroll
                    for (int k = 0; k < 4; ++k) { const float s0 = sigmoidf_(cl(bf_lo(bw[k]))), s1 = sigmoidf_(cl(bf_hi(bw[k])));
                        o[2 * k] = acc[ai][bj][m][k >> 1][(k & 1) * 2] * s0; o[2 * k + 1] = acc[ai][bj][m][k >> 1][(k & 1) * 2 + 1] * s1; }
                    u32x4 w; w.x = cvt_pk_bf16(o[0], o[1]); w.y = cvt_pk_bf16(o[2], o[3]); w.z = cvt_pk_bf16(o[4], o[5]); w.w = cvt_pk_bf16(o[6], o[7]);
                    *(u32x4*)(rowp + bj * HALF) = w; }
                asm volatile("" ::: "memory"); }
    }
};

template <class Epi, class Sched, bool ALIGN_EPI = false, bool SP2 = false>
__device__ __forceinline__ void gemm_phase(PG8_LAS unsigned char* lds, const Gemm g, const Sched& S, const Epi& E) {
    const int tid = tidx(), wid = __builtin_amdgcn_readfirstlane(tid >> 6), lane = tid & 63, wr = wid >> 2, wc = wid & 3, fr = lane & 15, fq = lane >> 4;
    const int K = g.K, nt = K / BK, LD = g.ld;
    unsigned voffA[2], voffB[2];
#pragma unroll
    for (int i = 0; i < 2; ++i) { int R, C; stage_rc(tid * 16 + i * 8192, R, C); const int Rb = Epi::PERM ? ((R & ~31) + perm32(R & 31)) : R;
        voffA[i] = (unsigned)(R * LD + C) * 2u; voffB[i] = (unsigned)(Rb * LD + C) * 2u; }
    const size_t kstep = (size_t)(BK * 2);
    const size_t hstep = (size_t)HALF * LD * 2;
    const size_t tstep = 2 * hstep;
    const unsigned ldsw = (unsigned)wid * 1024u;
    const int aoff = lds_byte(wr * 64 + fr, fq * 8), boff = lds_byte(wc * 32 + fr, fq * 8);
#define PG8_SA(b, h) (((b) * 2 + (h)) * HTB)
#define PG8_SB(b, h) ((4 + (b) * 2 + (h)) * HTB)
#define PG8_STAGE(bufoff, gbase, voff) do { _Pragma("unroll") for (int _i = 0; _i < 2; ++_i) \
        __builtin_amdgcn_global_load_lds((const unsigned*)((const char*)(gbase) + (voff)[_i]), (PG8_LAS unsigned*)(lds + (bufoff) + ldsw + _i * 8192), 16, 0, 0); } while (0)
#define PG8_LDA(dst, b, h) do { _Pragma("unroll") for (int m = 0; m < 4; ++m) _Pragma("unroll") for (int k = 0; k < 2; ++k) dst[m][k] = *(const PG8_LAS bf16x8*)(lds + PG8_SA(b, h) + aoff + m * 2048 + k * 1024); } while (0)
#define PG8_LDB(dst, b, h) do { _Pragma("unroll") for (int n = 0; n < 2; ++n) _Pragma("unroll") for (int k = 0; k < 2; ++k) dst[n][k] = *(const PG8_LAS bf16x8*)(lds + PG8_SB(b, h) + boff + n * 2048 + k * 1024); } while (0)
#define PG8_MMA(ai, bj, At, Bt) do { __builtin_amdgcn_s_setprio(1); _Pragma("unroll") for (int m = 0; m < 4; ++m) _Pragma("unroll") for (int n = 0; n < 2; ++n) _Pragma("unroll") for (int k = 0; k < 2; ++k) \
        acc[ai][bj][m][n] = __builtin_amdgcn_mfma_f32_16x16x32_bf16(Bt[n][k], At[m][k], acc[ai][bj][m][n], 0, 0, 0); __builtin_amdgcn_s_setprio(0); } while (0)
#define PG8_WAIT_V(n) asm volatile("s_waitcnt vmcnt(" #n ")" ::: "memory")
#define PG8_WAIT_L(n) asm volatile("s_waitcnt lgkmcnt(" #n ")" ::: "memory")
#define PG8_BAR __builtin_amdgcn_s_barrier()
#define PG8_SCHED __builtin_amdgcn_sched_barrier(0)
    Unit cur, nxt; int ui = 0;
    if (!S.next(0, cur)) return;
    f32x4 acc[2][2][4][2];
#pragma unroll
    for (int a = 0; a < 2; ++a)
#pragma unroll
        for (int b = 0; b < 2; ++b)
#pragma unroll
            for (int m = 0; m < 4; ++m)
#pragma unroll
                for (int n = 0; n < 2; ++n) acc[a][b][m][n] = (f32x4){0.f, 0.f, 0.f, 0.f};
    bf16x8 At[4][2], B0[2][2], B1[2][2];
    const size_t kslice = (size_t)K * 2;
    const char* cA = (const char*)g.A + (size_t)cur.pm * tstep + (size_t)cur.kh * kslice; const char* cB = (const char*)g.Bt + (size_t)cur.pn * tstep + (size_t)cur.kh * kslice;
    S.a_ready(cur);
    if constexpr (SP2) {
        PG8_STAGE(PG8_SB(0, 0), cB, voffB); PG8_STAGE(PG8_SB(0, 1), cB + hstep, voffB); PG8_STAGE(PG8_SA(0, 0), cA, voffA); PG8_STAGE(PG8_SA(0, 1), cA + hstep, voffA);
        if (wr == 1) PG8_BAR;
        PG8_WAIT_V(2); PG8_BAR;
        PG8_STAGE(PG8_SB(1, 0), cB + kstep, voffB); PG8_STAGE(PG8_SA(1, 0), cA + kstep, voffA); PG8_STAGE(PG8_SB(1, 1), cB + hstep + kstep, voffB);
        PG8_WAIT_V(6); PG8_BAR;
    } else {
        PG8_STAGE(PG8_SB(0, 0), cB, voffB); PG8_STAGE(PG8_SA(0, 0), cA, voffA); PG8_STAGE(PG8_SB(0, 1), cB + hstep, voffB); PG8_STAGE(PG8_SA(0, 1), cA + hstep, voffA);
        if (wr == 1) PG8_BAR;
        PG8_WAIT_V(4); PG8_BAR;
        PG8_STAGE(PG8_SB(1, 0), cB + kstep, voffB); PG8_STAGE(PG8_SA(1, 0), cA + kstep, voffA); PG8_STAGE(PG8_SB(1, 1), cB + hstep + kstep, voffB);
        PG8_WAIT_V(6); PG8_BAR;
    }
    for (;;) {
        const bool has_next = S.next(ui + 1, nxt);
        const char* nA = has_next ? (const char*)g.A + (size_t)nxt.pm * tstep + (size_t)nxt.kh * kslice : cA; const char* nB = has_next ? (const char*)g.Bt + (size_t)nxt.pn * tstep + (size_t)nxt.kh * kslice : cB;
        for (int t = 0; t < nt; t += 2) {
            const bool last = (t == nt - 2);
            const char* a1 = cA + (size_t)(t + 1) * kstep;
            const char* a2 = last ? nA : cA + (size_t)(t + 2) * kstep; const char* b2 = last ? nB : cB + (size_t)(t + 2) * kstep;
            const char* a3 = a2 + kstep; const char* b3 = b2 + kstep;
            if (last && has_next) S.a_ready(nxt);
            if constexpr (SP2) {
            PG8_LDB(B0, 0, 0); PG8_LDB(B1, 0, 1); PG8_SCHED; PG8_LDA(At, 0, 0); PG8_STAGE(PG8_SA(1, 1), a1 + hstep, voffA);
            PG8_WAIT_V(8); PG8_WAIT_L(0); PG8_BAR; PG8_MMA(0, 0, At, B0); PG8_MMA(0, 1, At, B1); PG8_BAR; PG8_SCHED;
            PG8_LDA(At, 0, 1); PG8_STAGE(PG8_SB(0, 0), b2, voffB); PG8_STAGE(PG8_SB(0, 1), b2 + hstep, voffB); PG8_STAGE(PG8_SA(0, 0), a2, voffA);
            PG8_WAIT_V(8); PG8_WAIT_L(0); PG8_BAR; PG8_MMA(1, 0, At, B0); PG8_MMA(1, 1, At, B1); PG8_BAR; PG8_SCHED;
            PG8_LDB(B0, 1, 0); PG8_LDB(B1, 1, 1); PG8_SCHED; PG8_LDA(At, 1, 0); PG8_STAGE(PG8_SA(0, 1), a2 + hstep, voffA);
            PG8_WAIT_V(8); PG8_WAIT_L(0); PG8_BAR; PG8_MMA(0, 0, At, B0); PG8_MMA(0, 1, At, B1); PG8_BAR; PG8_SCHED;
            PG8_LDA(At, 1, 1); PG8_STAGE(PG8_SB(1, 0), b3, voffB); PG8_STAGE(PG8_SB(1, 1), b3 + hstep, voffB); PG8_STAGE(PG8_SA(1, 0), a3, voffA);
            PG8_WAIT_V(8); PG8_WAIT_L(0); PG8_BAR; PG8_MMA(1, 0, At, B0); PG8_MMA(1, 1, At, B1); PG8_BAR; PG8_SCHED;
            } else {
            PG8_LDB(B0, 0, 0); PG8_SCHED; PG8_LDA(At, 0, 0); PG8_STAGE(PG8_SA(1, 1), a1 + hstep, voffA);
            PG8_WAIT_L(8); PG8_BAR; PG8_WAIT_L(0); PG8_MMA(0, 0, At, B0); PG8_BAR; PG8_SCHED;
            PG8_LDB(B1, 0, 1); PG8_STAGE(PG8_SB(0, 0), b2, voffB);
            PG8_BAR; PG8_WAIT_L(0); PG8_MMA(0, 1, At, B1); PG8_BAR;
            PG8_LDA(At, 0, 1); PG8_STAGE(PG8_SA(0, 0), a2, voffA);
            PG8_BAR; PG8_WAIT_L(0); PG8_MMA(1, 0, At, B0); PG8_BAR; PG8_SCHED;
            PG8_STAGE(PG8_SB(0, 1), b2 + hstep, voffB);
            PG8_WAIT_V(6); PG8_BAR; PG8_MMA(1, 1, At, B1); PG8_BAR;
            PG8_LDB(B0, 1, 0); PG8_SCHED; PG8_LDA(At, 1, 0); PG8_STAGE(PG8_SA(0, 1), a2 + hstep, voffA);
            PG8_WAIT_L(8); PG8_BAR; PG8_WAIT_L(0); PG8_MMA(0, 0, At, B0); PG8_BAR; PG8_SCHED;
            PG8_LDB(B1, 1, 1); PG8_STAGE(PG8_SB(1, 0), b3, voffB);
            PG8_BAR; PG8_WAIT_L(0); PG8_MMA(0, 1, At, B1); PG8_BAR;
            PG8_LDA(At, 1, 1); PG8_STAGE(PG8_SA(1, 0), a3, voffA);
            PG8_BAR; PG8_WAIT_L(0); PG8_MMA(1, 0, At, B0); PG8_BAR; PG8_SCHED;
            PG8_STAGE(PG8_SB(1, 1), b3 + hstep, voffB);
            PG8_WAIT_V(6); PG8_BAR; PG8_MMA(1, 1, At, B1); PG8_BAR;
            }
        }
        if constexpr (ALIGN_EPI) { if (wr == 0) PG8_BAR; }
        if constexpr (!Epi::AFTER_DRAIN) { E(acc, cur, wr, wc, fr, fq); S.done(cur); }
        if (!has_next) break;
        if (!(Epi::MID && cur.kh == 0)) {
#pragma unroll
        for (int a = 0; a < 2; ++a)
#pragma unroll
            for (int b = 0; b < 2; ++b)
#pragma unroll
                for (int m = 0; m < 4; ++m)
#pragma unroll
                    for (int n = 0; n < 2; ++n) acc[a][b][m][n] = (f32x4){0.f, 0.f, 0.f, 0.f};
        }
        cur = nxt; cA = nA; cB = nB; ++ui;
        if constexpr (ALIGN_EPI) { if (wr == 1) PG8_BAR; }
    }
    PG8_WAIT_V(0);
    if constexpr (!ALIGN_EPI) { if (wr == 0) PG8_BAR; }
    PG8_BAR;
    if constexpr (Epi::AFTER_DRAIN) { E.fused(acc, cur, wr, wc, fr, fq, lds, wid, lane); S.done(cur); }
#undef PG8_SA
#undef PG8_SB
#undef PG8_STAGE
#undef PG8_LDA
#undef PG8_LDB
#undef PG8_MMA
#undef PG8_WAIT_V
#undef PG8_WAIT_L
#undef PG8_BAR
#undef PG8_SCHED
}
}

namespace attn {
constexpr int D = 128;
constexpr float THR = 8.f;
constexpr bool WSKIP = false;
constexpr int LDP = 16384, LDO = 2048;
constexpr float SCALE = 0.08838834764831845f;
constexpr int NW = 8, QBLK = 32, KVBLK = 64, QB = NW * QBLK;
constexpr int SHM_V = KVBLK * D * 2, SHM_K = KVBLK * D * 2;
constexpr int LDS_BYTES = 2 * SHM_V + 2 * SHM_K + NW * 64 * 4;

using bf16 = __hip_bfloat16;
typedef short bf16x8 __attribute__((ext_vector_type(8)));
typedef short s16x4 __attribute__((ext_vector_type(4)));
typedef float f32x16 __attribute__((ext_vector_type(16)));
typedef float f32x4 __attribute__((ext_vector_type(4)));
typedef unsigned u32x4 __attribute__((ext_vector_type(4)));
template <class A, class Bt> struct same_t { static constexpr bool v = false; };
template <class A> struct same_t<A, A> { static constexpr bool v = true; };

#define KSWZ(row, colB) ((row) * 256 + ((colB) ^ (((row) & 7) << 4)))
#define SBAR() __builtin_amdgcn_sched_barrier(0)
__device__ __forceinline__ int v_st(int k, int c) { const int kk = (k & ~0xC) | ((k & 4) << 1) | ((k & 8) >> 1); return ((kk >> 3) * 4 + (c >> 5)) * 512 + ((kk & 7) * 32 + (c & 31)) * 2; }
__device__ __forceinline__ int v_rd_base(int lane) { return ((lane & 3) << 3) | (((lane >> 2) & 3) << 6) | (((lane >> 4) & 1) << 5) | (((lane >> 5) & 1) << 8); }
constexpr int v_rd_off(int d0, int ks, int half) { return d0 * 512 + ks * 4096 + half * 2048; }
__device__ __forceinline__ int crow(int r, int hi) { return (r & 3) + 8 * (r >> 2) + 4 * hi; }
__device__ __forceinline__ unsigned cvtpk(float lo, float hi) {
    unsigned r; asm volatile("v_cvt_pk_bf16_f32 %0, %1, %2" : "=v"(r) : "v"(lo), "v"(hi)); return r;
}
__device__ __forceinline__ bf16x8 pack8(f32x4 a, f32x4 b) {
    u32x4 w = {cvtpk(a[0], a[1]), cvtpk(a[2], a[3]), cvtpk(b[0], b[1]), cvtpk(b[2], b[3])};
    return *reinterpret_cast<bf16x8*>(&w);
}
template <class T> __device__ __forceinline__ bf16x8 load8(const T* p) {
    if constexpr (same_t<T, float>::v) { return pack8(*(const f32x4*)p, *(const f32x4*)(p + 4)); }
    else { return *reinterpret_cast<const bf16x8*>(p); }
}
__device__ __forceinline__ void mask_tile(f32x16& p0, f32x16& p1, int dq, unsigned W) {
    const float NEG = -__builtin_inff();
#pragma unroll
    for (int r = 0; r < 16; ++r) {
        const int c = (r & 3) + 8 * (r >> 2);
        if ((unsigned)(dq - c) >= W) p0[r] = NEG;
        if ((unsigned)(dq - c - 32) >= W) p1[r] = NEG;
    }
}
__device__ __forceinline__ void partialSM(f32x16& p0, f32x16& p1, float& m_reg, float& mn, float& alpha) {
    float pmax = p0[0]; for (int r = 1; r < 16; ++r) pmax = fmaxf(pmax, p0[r]); for (int r = 0; r < 16; ++r) pmax = fmaxf(pmax, p1[r]);
    { auto rr = __builtin_amdgcn_permlane32_swap(__float_as_uint(pmax), __float_as_uint(pmax), false, false);
      pmax = fmaxf(__uint_as_float(rr[0]), __uint_as_float(rr[1])); }
    constexpr float C2 = 1.4426950408889634f * SCALE;
    if (__builtin_expect(__all((pmax - m_reg) * SCALE <= THR), 1)) { mn = m_reg; alpha = 1.f; }
    else { mn = fmaxf(m_reg, pmax); alpha = __builtin_amdgcn_exp2f((m_reg - mn) * C2); m_reg = mn; }
    const float mnL = -mn * C2;
    for (int r = 0; r < 16; ++r) p0[r] = fmaf(p0[r], C2, mnL); for (int r = 0; r < 16; ++r) p1[r] = fmaf(p1[r], C2, mnL);
    for (int r = 0; r < 16; ++r) p0[r] = __builtin_amdgcn_exp2f(p0[r]);
}
__device__ __forceinline__ void finishSM(f32x16& p0, f32x16& p1, float alpha, float& l_reg, bf16x8& pa0, bf16x8& pa1, bf16x8& pa2, bf16x8& pa3) {
    for (int r = 0; r < 16; ++r) p1[r] = __builtin_amdgcn_exp2f(p1[r]);
    float ps = 0; for (int r = 0; r < 16; ++r) ps += p0[r]; for (int r = 0; r < 16; ++r) ps += p1[r];
    { auto rr = __builtin_amdgcn_permlane32_swap(__float_as_uint(ps), __float_as_uint(ps), false, false);
      ps = __uint_as_float(rr[0]) + __uint_as_float(rr[1]); }
    l_reg = l_reg * alpha + ps;
#define PK4(P, B_, OUT) do { unsigned a0 = cvtpk(P[B_+0], P[B_+1]), a1 = cvtpk(P[B_+2], P[B_+3]);                          \
        unsigned b0 = cvtpk(P[B_+4], P[B_+5]), b1 = cvtpk(P[B_+6], P[B_+7]);                                             \
        auto r0 = __builtin_amdgcn_permlane32_swap(a0, b0, false, false); auto r1 = __builtin_amdgcn_permlane32_swap(a1, b1, false, false); \
        u32x4 w = {r0[0], r1[0], r0[1], r1[1]}; OUT = *reinterpret_cast<bf16x8*>(&w); } while (0)
    PK4(p0, 0, pa0); PK4(p0, 8, pa1); PK4(p1, 0, pa2); PK4(p1, 8, pa3);
#undef PK4
}
template <int KB, bool SK>
__device__ __forceinline__ void qkt(f32x16& p0, f32x16& p1, const char* K_lds, int r32, int hi, const bf16x8* qr, bool act) {
    if (SK && !act) { const float NEG = -__builtin_inff();
#pragma unroll
        for (int r = 0; r < 16; ++r) { p0[r] = NEG; p1[r] = NEG; } return; }
    p0 = f32x16{}; p1 = f32x16{};
    const char* kb[4];
#pragma unroll
    for (int dd = 0; dd < 4; ++dd) kb[dd] = K_lds + KB * SHM_K + KSWZ(r32, (dd * 16 + hi * 8) * 2);
#pragma unroll
    for (int d0 = 0; d0 < 8; ++d0) { const char* a = kb[d0 & 3] + (d0 >> 2) * 128;
        bf16x8 b0 = *reinterpret_cast<const bf16x8*>(a);
        bf16x8 b1 = *reinterpret_cast<const bf16x8*>(a + 32 * 256);
        p0 = __builtin_amdgcn_mfma_f32_32x32x16_bf16(b0, qr[d0], p0, 0, 0, 0);
        p1 = __builtin_amdgcn_mfma_f32_32x32x16_bf16(b1, qr[d0], p1, 0, 0, 0); }
}
template <int KB>
__device__ __forceinline__ void qkt2(f32x16& p0, f32x16& p1, int ka0, int ka1, int ka2, int ka3, int ka4, int ka5, int ka6, int ka7, const bf16x8* qr) {
#define KRD(dst, a, off) asm volatile("ds_read_b128 %0, %1 offset:%2" : "=&v"(dst) : "v"(a), "i"(off) : "memory")
#define KRD4(S, aE, aO, g) do { constexpr int o_ = KB * SHM_K;     \
        KRD(S##0, aE, o_); KRD(S##1, aE, o_ + 8192); KRD(S##2, aO, o_); KRD(S##3, aO, o_ + 8192); } while (0)
#define KMM(S, g) do { p0 = __builtin_amdgcn_mfma_f32_32x32x16_bf16(S##0, qr[2 * (g)], p0, 0, 0, 0); p1 = __builtin_amdgcn_mfma_f32_32x32x16_bf16(S##1, qr[2 * (g)], p1, 0, 0, 0); \
        p0 = __builtin_amdgcn_mfma_f32_32x32x16_bf16(S##2, qr[2 * (g) + 1], p0, 0, 0, 0); p1 = __builtin_amdgcn_mfma_f32_32x32x16_bf16(S##3, qr[2 * (g) + 1], p1, 0, 0, 0); } while (0)
#define KW(n) do { asm volatile("s_waitcnt lgkmcnt(" #n ")" ::: "memory"); SBAR(); } while (0)
    bf16x8 X0, X1, X2, X3, Y0, Y1, Y2, Y3;
    p0 = f32x16{}; p1 = f32x16{};
    KRD4(X, ka0, ka1, 0);
    KRD4(Y, ka2, ka3, 1); KW(4); KMM(X, 0);
    KRD4(X, ka4, ka5, 2); KW(4); KMM(Y, 1);
    KRD4(Y, ka6, ka7, 3); KW(4); KMM(X, 2);
    KW(0); KMM(Y, 3);
#undef KRD
#undef KRD4
#undef KMM
#undef KW
}
template <int VB, bool SK>
__device__ __forceinline__ void pv_tile(f32x16* o, int vb0, bf16x8 pa0, bf16x8 pa1, bf16x8 pa2, bf16x8 pa3, bool act) {
    if (SK && !act) return;
#define TRRD(dst, off) asm volatile("ds_read_b64_tr_b16 %0, %1 offset:%2" : "=&v"(dst) : "v"(vb0), "i"(off) : "memory")
#define PV_D0(d0) do { s16x4 l0, l1, l2, l3, h0, h1, h2, h3; constexpr int b_ = VB * SHM_V + v_rd_off(d0, 0, 0);     \
        TRRD(l0, b_); TRRD(h0, b_ + 2048); TRRD(l1, b_ + 4096); TRRD(h1, b_ + 6144); TRRD(l2, b_ + 8192); TRRD(h2, b_ + 10240); TRRD(l3, b_ + 12288); TRRD(h3, b_ + 14336); \
        asm volatile("s_waitcnt lgkmcnt(0)" ::: "memory"); SBAR();                 \
        o[d0] = __builtin_amdgcn_mfma_f32_32x32x16_bf16(pa0, (bf16x8){l0[0], l0[1], l0[2], l0[3], h0[0], h0[1], h0[2], h0[3]}, o[d0], 0, 0, 0);   \
        o[d0] = __builtin_amdgcn_mfma_f32_32x32x16_bf16(pa1, (bf16x8){l1[0], l1[1], l1[2], l1[3], h1[0], h1[1], h1[2], h1[3]}, o[d0], 0, 0, 0);   \
        o[d0] = __builtin_amdgcn_mfma_f32_32x32x16_bf16(pa2, (bf16x8){l2[0], l2[1], l2[2], l2[3], h2[0], h2[1], h2[2], h2[3]}, o[d0], 0, 0, 0);   \
        o[d0] = __builtin_amdgcn_mfma_f32_32x32x16_bf16(pa3, (bf16x8){l3[0], l3[1], l3[2], l3[3], h3[0], h3[1], h3[2], h3[3]}, o[d0], 0, 0, 0); } while (0)
    PV_D0(0); PV_D0(1); PV_D0(2); PV_D0(3);
#undef PV_D0
#undef TRRD
}

template <class TIn, class TOut> struct BlockRef { const TIn* Q; const TIn* K; const TIn* V; TOut* O; int P0; };
template <class TIn> struct Seam {
    bf16x8 qr[8];
    bf16x8 st_v0, st_v1, st_k0, st_k1; f32x4 sf0, sf1, sf2, sf3;
    f32x4 tq[16];
};
__device__ __forceinline__ int swa_jlo(int P0, int W) { const int lowk = P0 - W + 1; return lowk > 0 ? lowk / KVBLK : 0; }
#define ROW(p, k0, rr) ((p) + (size_t)((k0) + (rr)) * LDP + sc)
#define VMW() asm volatile("s_waitcnt vmcnt(0)" ::: "memory")
#define VMWN(n) asm volatile("s_waitcnt vmcnt(%0)" :: "i"(n) : "memory")
#define UPTR(p, off) ((const TIn*)((const char*)(p) + (unsigned)(off)))
#define SLOAD_H(Kp, Vp, k0) do { const TIn* kb_ = (Kp) + (size_t)(k0) * LDP; const TIn* vb_ = (Vp) + (size_t)(k0) * LDP;                     \
                         S.st_v0 = load8<TIn>(UPTR(vb_, toff)); S.st_v1 = load8<TIn>(UPTR(vb_ + 32 * LDP, toff));              \
                         S.st_k0 = load8<TIn>(UPTR(kb_, toff)); S.st_k1 = load8<TIn>(UPTR(kb_ + 32 * LDP, toff)); } while (0)
#define SWRITE_HK(bf) do { *(bf16x8*)(K_lds + (bf) * SHM_K + kws) = S.st_k0; *(bf16x8*)(K_lds + (bf) * SHM_K + kws + 32 * 256) = S.st_k1; } while (0)
#define SWRITE_HV(bf) do { *(bf16x8*)(V_lds + (bf) * SHM_V + vst0) = S.st_v0; *(bf16x8*)(V_lds + (bf) * SHM_V + vst1) = S.st_v1; } while (0)
#define SWRITE_H(bf) do { SWRITE_HV(bf); SWRITE_HK(bf); } while (0)
#define SLOAD_F(p, k0) do { S.sf0 = *(const f32x4*)ROW(p, k0, sr); S.sf1 = *(const f32x4*)(ROW(p, k0, sr) + 4);                \
                            S.sf2 = *(const f32x4*)ROW(p, k0, 32 + sr); S.sf3 = *(const f32x4*)(ROW(p, k0, 32 + sr) + 4); } while (0)
#define SWRITE_KF(bf) do { *(bf16x8*)(K_lds + (bf) * SHM_K + kws) = pack8(S.sf0, S.sf1); *(bf16x8*)(K_lds + (bf) * SHM_K + kws + 32 * 256) = pack8(S.sf2, S.sf3); } while (0)
#define SWRITE_VF(bf) do { *(bf16x8*)(V_lds + (bf) * SHM_V + vst0) = pack8(S.sf0, S.sf1); *(bf16x8*)(V_lds + (bf) * SHM_V + vst1) = pack8(S.sf2, S.sf3); } while (0)
template <class TIn, class TOut>
__device__ __forceinline__ void causal_swa_prime(const BlockRef<TIn, TOut>& cur, int W, char* lds, Seam<TIn>& S) {
    constexpr bool F32 = same_t<TIn, float>::v;
    const int tid = tidx(), wid = __builtin_amdgcn_readfirstlane(tid >> 6), lane = tid & 63, r32 = lane & 31, hi = lane >> 5;
    const int sr = tid >> 4, sc = (tid & 15) * 8, kws = KSWZ(sr, sc * 2); char* K_lds = lds + 2 * SHM_V; const unsigned toff = (unsigned)(sr * LDP + sc) * 2u;
    const int kb0 = swa_jlo(cur.P0, W) * KVBLK;
    for (int d0 = 0; d0 < 8; ++d0) S.qr[d0] = load8<TIn>(UPTR(cur.Q + (size_t)(wid * QBLK) * LDP + d0 * 16, (unsigned)(r32 * LDP + hi * 8) * 2u));
    if constexpr (F32) { SLOAD_F((const float*)cur.K, kb0); VMW(); SWRITE_KF(0); SBAR(); SLOAD_F((const float*)cur.V, kb0); }
    else { SLOAD_H(cur.K, cur.V, kb0); VMW(); SWRITE_HK(0); }
    __syncthreads();
}
template <class TIn, class TOut>
__device__ __forceinline__ void causal_swa_block(const BlockRef<TIn, TOut>& cur, const BlockRef<TIn, TOut>& nxt, int skv, int W, char* lds, Seam<TIn>& S) {
    constexpr bool F32 = same_t<TIn, float>::v;
    const int tid = tidx(), wid = __builtin_amdgcn_readfirstlane(tid >> 6), lane = tid & 63, r32 = lane & 31, hi = lane >> 5;
    const int j_lo = swa_jlo(cur.P0, W);
    int j_hi = (cur.P0 + QB - 1) / KVBLK + 1; if (j_hi > skv / KVBLK) j_hi = skv / KVBLK;
    const int NT = j_hi - j_lo;
    const int kbn = swa_jlo(nxt.P0, W) * KVBLK;
    const int qlo = cur.P0 + wid * QBLK, qm = qlo + r32 - 4 * hi;
    char* V_lds = lds; char* K_lds = lds + 2 * SHM_V;
    float* ws = (float*)(lds + 2 * SHM_V + 2 * SHM_K) + wid * 64; float* li_l = ws, * al_l = ws + 32;
    float m_reg = -1e30f, l_reg = 0; f32x16 o[4] = {};
    const int sr = tid >> 4, sc = (tid & 15) * 8, vst0 = v_st(sr, sc), vst1 = vst0 + 8192  , kws = KSWZ(sr, sc * 2); const unsigned toff = (unsigned)(sr * LDP + sc) * 2u;
    const int vb0 = (int)(uintptr_t)V_lds + v_rd_base(lane);
    const TIn* Kh = cur.K; const TIn* Vh = cur.V;
#define RESC(a) do { if (__any((a) < 1.f)) { if (hi == 0) al_l[r32] = (a); asm volatile("s_waitcnt lgkmcnt(0)" ::: "memory");              \
                     for (int d_ = 0; d_ < 4; ++d_) for (int r = 0; r < 16; ++r) o[d_][r] *= al_l[crow(r, hi)]; } } while (0)
#define KBASE(t) ((j_lo + (t)) * KVBLK)
#define ACT(t) (KBASE(t) <= qlo + QBLK - 1 && KBASE(t) + KVBLK - 1 >= qlo - W + 1)
#define MASKT(P0_, P1_, t) do { const int kb_ = KBASE(t); if ((!SK || ACT(t)) && (kb_ + KVBLK - 1 > qlo || kb_ <= qlo + QBLK - 1 - W)) mask_tile(P0_, P1_, qm - kb_, (unsigned)W); } while (0)
    constexpr int NQL = F32 ? 16 : 8;
    constexpr bool SK = WSKIP && !F32;
#define SEAM_K0() do { VMWN(NQL); if constexpr (F32) { SWRITE_KF(0); SBAR(); SLOAD_F((const float*)nxt.V, kbn); } else { SWRITE_HK(0); } SBAR(); } while (0)
    f32x16 pA0, pA1, pB0, pB1; float mnA, mnB, alA, alB; bf16x8 pa0, pa1, pa2, pa3;
    if constexpr (F32) { VMW(); SWRITE_VF(0); SBAR(); } else { SWRITE_HV(0); SBAR(); }
    if (NT > 1) { if constexpr (F32) SLOAD_F((const float*)Kh, KBASE(1)); else SLOAD_H(Kh, Vh, KBASE(1)); }
    SBAR(); qkt<0, SK>(pA0, pA1, K_lds, r32, hi, S.qr, ACT(0));
    if constexpr (F32) { if (NT > 1) { VMW(); SWRITE_KF(1); SBAR(); SLOAD_F((const float*)Vh, KBASE(1)); } }
    MASKT(pA0, pA1, 0); partialSM(pA0, pA1, m_reg, mnA, alA);
    if (NT > 1) { VMW(); if constexpr (F32) { SWRITE_VF(1); SBAR(); if (NT > 2) SLOAD_F((const float*)Kh, KBASE(2)); } else SWRITE_H(1); }
    __syncthreads();
#define HALF_STEP(PX0, PX1, mnX, alX, PY0, PY1, alY, t, KB, VB, SB) do {                                                      \
        SBAR(); qkt<KB, SK>(PX0, PX1, K_lds, r32, hi, S.qr, ACT(t));                                             \
        finishSM(PY0, PY1, alY, l_reg, pa0, pa1, pa2, pa3); SBAR();                                                           \
        if ((t) + 1 < NT) { if constexpr (F32) { VMW(); SWRITE_KF(SB); SBAR(); SLOAD_F((const float*)Vh, KBASE((t) + 1)); }  \
                            else { SLOAD_H(Kh, Vh, KBASE((t) + 1)); } SBAR(); }                                               \
        pv_tile<VB, SK>(o, vb0, pa0, pa1, pa2, pa3, ACT((t) - 1)); MASKT(PX0, PX1, (t)); partialSM(PX0, PX1, m_reg, mnX, alX);                                        \
        __syncthreads();                                                                                                      \
        if ((t) + 1 < NT) { VMW(); if constexpr (F32) { SWRITE_VF(SB); SBAR(); if ((t) + 2 < NT) SLOAD_F((const float*)Kh, KBASE((t) + 2)); } \
                            else { SWRITE_H(SB); } }                                                                          \
        RESC(alX); __syncthreads(); } while (0)
    for (int t = 1; t + 1 < NT; t += 2) {
        HALF_STEP(pB0, pB1, mnB, alB, pA0, pA1, alA, t, 1, 0, 0);
        HALF_STEP(pA0, pA1, mnA, alA, pB0, pB1, alB, t + 1, 0, 1, 1);
    }
    const bool even = (NT & 1) == 0;
    if (even) { SBAR(); qkt<1, SK>(pB0, pB1, K_lds, r32, hi, S.qr, ACT(NT - 1)); SBAR(); }
#define QROW(e) (nxt.Q + (size_t)(wid * QBLK + r32) * LDP + ((e) >> 1) * 16 + hi * 8 + ((e) & 1) * 4)
    if constexpr (F32) { SLOAD_F((const float*)nxt.K, kbn); SBAR();
#pragma unroll
        for (int e = 0; e < 8; ++e) S.tq[e] = *(const f32x4*)QROW(e); }
    else { SLOAD_H(nxt.K, nxt.V, kbn); SBAR();
#pragma unroll
        for (int d0 = 0; d0 < 8; ++d0) S.qr[d0] = load8<TIn>(UPTR(nxt.Q + (size_t)(wid * QBLK) * LDP + d0 * 16, (unsigned)(r32 * LDP + hi * 8) * 2u)); }
    SBAR();
    finishSM(pA0, pA1, alA, l_reg, pa0, pa1, pa2, pa3); SBAR();
    if constexpr (F32) {
#pragma unroll
        for (int e = 8; e < 16; ++e) S.tq[e] = *(const f32x4*)QROW(e); SBAR(); }
#undef QROW
    pv_tile<0, SK>(o, vb0, pa0, pa1, pa2, pa3, ACT(even ? NT - 2 : NT - 1));
    if (even) { MASKT(pB0, pB1, NT - 1); partialSM(pB0, pB1, m_reg, mnB, alB); __syncthreads(); RESC(alB);
        finishSM(pB0, pB1, alB, l_reg, pa0, pa1, pa2, pa3); SBAR(); pv_tile<1, SK>(o, vb0, pa0, pa1, pa2, pa3, ACT(NT - 1)); }
    SBAR(); SEAM_K0();
    if (hi == 0) li_l[r32] = l_reg; asm volatile("s_waitcnt lgkmcnt(0)" ::: "memory");
    float rli[16];
#pragma unroll
    for (int r = 0; r < 16; ++r) rli[r] = __builtin_amdgcn_rcpf(li_l[crow(r, hi)]);
    TOut* Ow = cur.O + (size_t)(wid * QBLK) * LDO;
#pragma unroll
    for (int r = 0; r < 16; ++r) { const int orow = crow(r, hi);
#pragma unroll
        for (int d0 = 0; d0 < 4; ++d0) { const float v = o[d0][r] * rli[r];
            if constexpr (same_t<TOut, float>::v) { Ow[(size_t)orow * LDO + d0 * 32 + r32] = v; }
            else { const float vn = __builtin_bit_cast(float, __builtin_amdgcn_update_dpp(0, __builtin_bit_cast(int, v), 0xB1, 0xf, 0xf, false));
                   if ((r32 & 1) == 0) *(unsigned*)(Ow + (size_t)orow * LDO + d0 * 32 + r32) = cvtpk(v, vn); } } }
    if constexpr (F32) {
#pragma unroll
        for (int d0 = 0; d0 < 8; ++d0) S.qr[d0] = pack8(S.tq[2 * d0], S.tq[2 * d0 + 1]); }
    __syncthreads();
#undef RESC
#undef KBASE
#undef ACT
#undef MASKT
#undef SEAM_K0
#undef HALF_STEP
}
#undef ROW
#undef VMW
#undef VMWN
#undef SLOAD_H
#undef UPTR
#undef SWRITE_HK
#undef SWRITE_HV
#undef SWRITE_H
#undef SLOAD_F
#undef SWRITE_KF
#undef SWRITE_VF

#undef KSWZ
#undef SBAR
}

#define GAS __attribute__((address_space(1)))
#define LAS __attribute__((address_space(3)))
typedef unsigned short bf16;
typedef unsigned v4u __attribute__((ext_vector_type(4)));
typedef float f32x4 __attribute__((ext_vector_type(4)));
typedef short bf16x8 __attribute__((ext_vector_type(8)));
typedef GAS unsigned gu32;
typedef GAS unsigned long long gu64;
#define RLX_AGENT __ATOMIC_RELAXED, __HIP_MEMORY_SCOPE_AGENT
#define LDS_WAIT() asm volatile("s_waitcnt lgkmcnt(0)" ::: "memory")
#define VM_WAIT() asm volatile("s_waitcnt vmcnt(0)" ::: "memory")
__device__ __forceinline__ unsigned long long rt() { return __builtin_amdgcn_s_memrealtime(); }
__device__ __forceinline__ unsigned f2bf(float f) { unsigned u = __builtin_bit_cast(unsigned, f); return (u + 0x7fffu + ((u >> 16) & 1u)) >> 16; }
__device__ __forceinline__ unsigned pk2(float lo, float hi) { return f2bf(lo) | (f2bf(hi) << 16); }

#define XB_TMO      128
#define XB_XCNT(j)  (256  + 64 * (j))
#define XB_XSUB(j)  (1280 + 64 * (j))
#define XB_XGEN(j)  (2304 + 64 * (j))
#define XB_TOP      3328
#define XB_TOPGEN   3392
#define XCD_BAR_WORDS 3456
#define XB_SPIN_CAP (1u << 18)

__device__ __forceinline__ unsigned xb_ld(unsigned* p)              { return __hip_atomic_load(p, __ATOMIC_RELAXED, __HIP_MEMORY_SCOPE_AGENT); }
__device__ __forceinline__ unsigned xb_add(unsigned* p, unsigned v) { return __hip_atomic_fetch_add(p, v, __ATOMIC_RELAXED, __HIP_MEMORY_SCOPE_AGENT); }
__device__ __forceinline__ unsigned xb_xcc_id() { return (unsigned)__builtin_amdgcn_s_getreg((3 << 11) | 20) & 0xFu; }
#define XB_SPIN(cond, bar) do { unsigned _sp = 0; while (cond) { __builtin_amdgcn_s_sleep(1); \
    if ((++_sp & 255u) == 0u) { if (xb_ld(&(bar)[XB_TMO])) break; if (_sp > XB_SPIN_CAP) { atomicAdd(&(bar)[XB_TMO], 1u); break; } } } } while (0)

struct XcdBarrier {
    unsigned* bar; unsigned x;
    volatile LAS unsigned* st;
};

__device__ __forceinline__ XcdBarrier xcd_barrier_post(unsigned* bar, volatile LAS unsigned* st) {
    XcdBarrier b; b.bar = bar; b.x = xb_xcc_id(); b.st = st;
    if (tidx() == 0) (void)xb_add(&bar[XB_XCNT(b.x)], 1u);
    return b;
}
__device__ __forceinline__ void xcd_barrier_complete(unsigned* bar, unsigned x, unsigned& nloc, unsigned& nx) {
    const unsigned G = gridDim.x * gridDim.y * gridDim.z;
    unsigned sum, cnt, mine, sp = 0u;
    for (;;) {
        sum = 0u; cnt = 0u; mine = 0u;
#pragma unroll
        for (unsigned j = 0; j < 16; ++j) { const unsigned c = xb_ld(&bar[XB_XCNT(j)]); sum += c; cnt += (c > 0u) ? 1u : 0u; mine = (j == x) ? c : mine; }
        if (sum == G) break;
        __builtin_amdgcn_s_sleep(1);
        if ((++sp & 255u) == 0u) { if (xb_ld(&bar[XB_TMO])) break; if (sp > XB_SPIN_CAP) { atomicAdd(&bar[XB_TMO], 1u); break; } }
    }
    nloc = mine > 0u ? mine : 1u; nx = cnt > 0u ? cnt : 1u;
}

__device__ __forceinline__ void xcd_barrier(const XcdBarrier& b) {
    asm volatile("s_waitcnt vmcnt(0)" ::: "memory");
    __syncthreads();
    if (tidx() == 0) {
        unsigned* bar = b.bar;
        __builtin_amdgcn_s_waitcnt(0);
        unsigned nloc = b.st[0], nx = b.st[1];
        if (nloc == 0u) { xcd_barrier_complete(bar, b.x, nloc, nx); b.st[0] = nloc; b.st[1] = nx; }
        const unsigned old = xb_add(&bar[XB_XSUB(b.x)], 1u);
        const unsigned gen = old / nloc;
        if (old + 1u == (gen + 1u) * nloc) {
            __builtin_amdgcn_fence(__ATOMIC_RELEASE, "agent");
            asm volatile("s_waitcnt vmcnt(0)" ::: "memory");
            const unsigned og = xb_add(&bar[XB_TOP], 1u);
            const unsigned tg = og / nx;
            if (og + 1u == (tg + 1u) * nx) xb_add(&bar[XB_TOPGEN], 1u);
            else XB_SPIN(xb_ld(&bar[XB_TOPGEN]) == tg, bar);
            __builtin_amdgcn_fence(__ATOMIC_ACQUIRE, "agent");
            xb_add(&bar[XB_XGEN(b.x)], 1u);
            asm volatile("s_waitcnt vmcnt(0)" ::: "memory");
        } else {
            XB_SPIN(xb_ld(&bar[XB_XGEN(b.x)]) == gen, bar);
            __builtin_amdgcn_fence(__ATOMIC_ACQUIRE, "agent");
            asm volatile("s_waitcnt vmcnt(0)" ::: "memory");
        }
    }
    __syncthreads();
}

constexpr int DM = 2048, NBATCH = 4, SEQ = 4096, DEPTH = 4, MTOK = NBATCH * SEQ;
constexpr int N_IN = 16400, NP = 16384, DFF = 5632, NHEAD = 8;
constexpr float EPS = 1e-6f;
constexpr int C_MQ = 0, C_MK = 1024, C_MV = 2048, C_MO = 4096, C_DQ = 6144, C_DK = 8192, C_DV = 10240, C_GM = 12288, C_GD = 14336;
constexpr int SRC_GATE = 6144;

constexpr size_t MiB = 1u << 20;
constexpr size_t WS_CTL = 0, CTL_ZERO_BYTES = 1 * MiB;
constexpr size_t WS_W1 = 1 * MiB;
constexpr size_t WS_W2 = 65 * MiB;
constexpr size_t WS_W3 = 81 * MiB;
constexpr size_t WS_W4 = 89 * MiB;
constexpr size_t WS_W5 = 133 * MiB;
constexpr size_t WS_X = 156 * MiB;
constexpr size_t WS_HB = 284 * MiB;
constexpr size_t WS_G = 348 * MiB;
constexpr size_t WS_SSQ = 349 * MiB;
constexpr size_t WS_HMF = 413 * MiB;
constexpr size_t WS_HD1 = 541 * MiB;
constexpr size_t WS_HD2 = 669 * MiB;
constexpr size_t WS_HMD = 797 * MiB;
constexpr size_t WS_Y = 925 * MiB;
constexpr size_t WS_P = 989 * MiB;
constexpr size_t WS_END = 1501 * MiB;
constexpr int CW_BAR = 4096;
constexpr int CW_Q = 8192;

constexpr int RING_BYTES = 147456, LDSCTL_OFF = RING_BYTES, MISC_OFF = LDSCTL_OFF + 320, PTR_OFF = LDSCTL_OFF + 1024, RT_OFF = LDSCTL_OFF + 2048  , LDS_BYTES = 163840;
constexpr int NWAVES = 8, NTHREADS = NWAVES * 64;
constexpr int MLSTM_WGS = 32;

__device__ __forceinline__ float bfbits2f(unsigned short h) { return __uint_as_float((unsigned)h << 16); }
__device__ __forceinline__ float wlo(unsigned w) { return __uint_as_float(w << 16); }
__device__ __forceinline__ float whi(unsigned w) { return __uint_as_float(w & 0xffff0000u); }
template <int CTRL> __device__ __forceinline__ float dpp_f(float x) { return __builtin_bit_cast(float, __builtin_amdgcn_update_dpp(0, __builtin_bit_cast(int, x), CTRL, 0xf, 0xf, false)); }
__device__ __forceinline__ float xor1_f(float v) { return dpp_f<0xB1>(v); }
__device__ __forceinline__ float sum4_f(float v) { v += dpp_f<0xB1>(v); v += dpp_f<0x4E>(v); return v; }
__device__ __forceinline__ float sum8_f(float v) { v = sum4_f(v); v += dpp_f<0x141>(v); return v; }
__device__ __forceinline__ float sum16_f(float v) { v = sum8_f(v); v += dpp_f<0x140>(v); return v; }
__device__ __forceinline__ float wave_sum(float v) {
    v = sum16_f(v);
    { auto r = __builtin_amdgcn_permlane16_swap(__float_as_uint(v), __float_as_uint(v), false, false); v = __uint_as_float(r[0]) + __uint_as_float(r[1]); }
    { auto r = __builtin_amdgcn_permlane32_swap(__float_as_uint(v), __float_as_uint(v), false, false); v = __uint_as_float(r[0]) + __uint_as_float(r[1]); }
    return v;
}
__device__ __forceinline__ float sigm(float x) { return __builtin_amdgcn_rcpf(1.0f + __expf(-x)); }
__device__ __forceinline__ float lam_init_of(int l) { return 0.8f - 0.6f * __expf(-0.3f * (float)l); }

__device__ __forceinline__ void tr_item(const float* W, int ldw, int scol0, int k0, const float* scale, float smul, bf16* WT, int ldt, LAS float* scr, int lane) {
    const int kr = lane >> 3, c4 = (lane & 7) * 4;
    f32x4 v[8]; float sc[8];
#pragma unroll
    for (int i = 0; i < 8; ++i) { v[i] = *(const GAS f32x4*)(W + (size_t)(k0 + 8 * i + kr) * ldw + scol0 + c4); sc[i] = scale ? scale[k0 + 8 * i + kr] * smul : 1.0f; }
#pragma unroll
    for (int i = 0; i < 8; ++i) { LAS float* d = scr + (8 * i + kr) * 33 + c4; d[0] = v[i].x * sc[i]; d[1] = v[i].y * sc[i]; d[2] = v[i].z * sc[i]; d[3] = v[i].w * sc[i]; }
    LDS_WAIT(); asm volatile("" ::: "memory");
    const int c = lane & 7;
#pragma unroll
    for (int j = 0; j < 4; ++j) { const int n = (lane >> 3) + 8 * j; const LAS float* s = scr + (8 * c) * 33 + n;
        v4u o; o.x = pk2(s[0 * 33], s[1 * 33]); o.y = pk2(s[2 * 33], s[3 * 33]); o.z = pk2(s[4 * 33], s[5 * 33]); o.w = pk2(s[6 * 33], s[7 * 33]);
        *(GAS v4u*)(WT + (size_t)n * ldt + k0 + 8 * c) = o; }
    LDS_WAIT(); asm volatile("" ::: "memory");
}

struct Args {
    const float* in[21]; float* out; unsigned char* ws;
    int l_lo, l_hi, ph_lo, ph_hi, do_final, use_bar, sub, qoff;
};
struct DArgs { LAS unsigned char* L; int l_lo, l_hi, ph_lo, ph_hi, do_final, use_bar, sub, qoff; };
__device__ __forceinline__ unsigned long long ptr_get(const DArgs& A, int i) {
    const unsigned long long v = ((const volatile LAS unsigned long long*)(A.L + PTR_OFF))[i];
    const unsigned lo = __builtin_amdgcn_readfirstlane((unsigned)v), hi = __builtin_amdgcn_readfirstlane((unsigned)(v >> 32));
    return ((unsigned long long)hi << 32) | lo;
}
__device__ __forceinline__ const float* inp(const DArgs& A, int i) { return (const float*)(const GAS float*)ptr_get(A, i); }
__device__ __forceinline__ float* outp(const DArgs& A) { return (float*)(GAS float*)ptr_get(A, 21); }
__device__ __forceinline__ unsigned char* wsp(const DArgs& A) { return (unsigned char*)(GAS unsigned char*)ptr_get(A, 22); }

struct WItem { const float* W; int ldw, scol0, k0; const float* scale; float smul; bf16* WT; int ldt; };
namespace wcv {
constexpr int I1 = (DM / 64) * (NP / 32), I2 = (DM / 64) * (DM / 32), I4 = (DM / 64) * (2 * DFF / 32), I5 = (DFF / 64) * (DM / 32);
constexpr int NITEMS = I1 + 3 * I2 + I4 + I5;
constexpr int NREST = NITEMS - I1;
}
__device__ __forceinline__ WItem weight_item(const DArgs& A, int l, int it) {
    using namespace wcv;
    unsigned char* ws = wsp(A); WItem w; int r = it;
    if (r < I1) { const int nblk = NP / 32, kb = r / nblk, nb = r % nblk, n0 = 32 * nb;
        w.W = inp(A, 2) + (size_t)l * DM * N_IN; w.ldw = N_IN; w.scol0 = n0 + (n0 >= SRC_GATE ? 16 : 0); w.k0 = 64 * kb; w.scale = inp(A, 1) + (size_t)l * DM; w.smul = 1.0f; w.WT = (bf16*)(ws + WS_W1) + (size_t)n0 * DM; w.ldt = DM; return w; } r -= I1;
    if (r < I2) { const int nblk = DM / 32, kb = r / nblk, nb = r % nblk, n0 = 32 * nb;
        w.W = inp(A, 13) + (size_t)l * DM * DM; w.ldw = DM; w.scol0 = n0; w.k0 = 64 * kb; w.scale = inp(A, 7) + (size_t)l * DM; w.smul = 1.0f; w.WT = (bf16*)(ws + WS_W2) + (size_t)n0 * (2 * DM); w.ldt = 2 * DM; return w; } r -= I2;
    if (r < I2) { const int nblk = DM / 32, kb = r / nblk, nb = r % nblk, n0 = 32 * nb;
        w.W = inp(A, 14) + (size_t)l * DM * DM; w.ldw = DM; w.scol0 = n0; w.k0 = 64 * kb; w.scale = inp(A, 12) + (size_t)l * DM; w.smul = 1.0f - lam_init_of(l); w.WT = (bf16*)(ws + WS_W2) + (size_t)n0 * (2 * DM) + DM; w.ldt = 2 * DM; return w; } r -= I2;
    if (r < I2) { const int nblk = DM / 32, kb = r / nblk, nb = r % nblk, n0 = 32 * nb;
        w.W = inp(A, 15) + (size_t)l * DM * DM; w.ldw = DM; w.scol0 = n0; w.k0 = 64 * kb; w.scale = nullptr; w.smul = 1.0f; w.WT = (bf16*)(ws + WS_W3) + (size_t)n0 * DM; w.ldt = DM; return w; } r -= I2;
    if (r < I4) { const int nblk = 2 * DFF / 32, kb = r / nblk, nb = r % nblk, n0 = 32 * nb, pn = n0 >> 8, j = n0 & 255;
        w.W = ((j < 128) ? inp(A, 17) : inp(A, 18)) + (size_t)l * DM * DFF; w.ldw = DFF; w.scol0 = pn * 128 + (j & 127); w.k0 = 64 * kb; w.scale = inp(A, 16) + (size_t)l * DM; w.smul = 1.0f; w.WT = (bf16*)(ws + WS_W4) + (size_t)n0 * DM; w.ldt = DM; return w; } r -= I4;
    { const int nblk = DM / 32, kb = r / nblk, nb = r % nblk, n0 = 32 * nb;
        w.W = inp(A, 19) + (size_t)l * DFF * DM; w.ldw = DM; w.scol0 = n0; w.k0 = 64 * kb; w.scale = nullptr; w.smul = 1.0f; w.WT = (bf16*)(ws + WS_W5) + (size_t)n0 * DFF; w.ldt = DFF; return w; }
}
__device__ __forceinline__ void tr_load(const WItem& w, f32x4 (&v)[8], float (&sc)[8], int lane) {
    const int kr = lane >> 3, c4 = (lane & 7) * 4;
#pragma unroll
    for (int i = 0; i < 8; ++i) { v[i] = __builtin_nontemporal_load((const GAS f32x4*)(w.W + (size_t)(w.k0 + 8 * i + kr) * w.ldw + w.scol0 + c4)); sc[i] = w.scale ? w.scale[w.k0 + 8 * i + kr] * w.smul : 1.0f; }
}
__device__ __forceinline__ void tr_load_data(const WItem& w, f32x4 (&v)[8], int lane) {
    const int kr = lane >> 3, c4 = (lane & 7) * 4;
#pragma unroll
    for (int i = 0; i < 8; ++i) v[i] = __builtin_nontemporal_load((const GAS f32x4*)(w.W + (size_t)(w.k0 + 8 * i + kr) * w.ldw + w.scol0 + c4));
}
__device__ __forceinline__ void tr_load_scale(const WItem& w, float (&sc)[8], int lane) {
    const int kr = lane >> 3;
#pragma unroll
    for (int i = 0; i < 8; ++i) sc[i] = w.scale ? w.scale[w.k0 + 8 * i + kr] * w.smul : 1.0f;
}
__device__ __forceinline__ void tr_store(const WItem& w, const f32x4 (&v)[8], const float (&sc)[8], LAS float* scr, int lane) {
    const int kr = lane >> 3, c4 = (lane & 7) * 4;
#pragma unroll
    for (int i = 0; i < 8; ++i) { LAS float* d = scr + (8 * i + kr) * 33 + c4; d[0] = v[i].x * sc[i]; d[1] = v[i].y * sc[i]; d[2] = v[i].z * sc[i]; d[3] = v[i].w * sc[i]; }
    LDS_WAIT(); asm volatile("" ::: "memory");
    const int c = lane & 7;
#pragma unroll
    for (int j = 0; j < 4; ++j) { const int n = (lane >> 3) + 8 * j; const LAS float* s = scr + (8 * c) * 33 + n;
        v4u o; o.x = pk2(s[0 * 33], s[1 * 33]); o.y = pk2(s[2 * 33], s[3 * 33]); o.z = pk2(s[4 * 33], s[5 * 33]); o.w = pk2(s[6 * 33], s[7 * 33]);
        *(GAS v4u*)(w.WT + (size_t)n * w.ldt + w.k0 + 8 * c) = o; }
    LDS_WAIT(); asm volatile("" ::: "memory");
}
__device__ __forceinline__ int wjob_chunks(int l) { return ((l + 1 < DEPTH) ? wcv::NITEMS : wcv::NREST) / 32; }
__device__ __forceinline__ WItem wjob_item(const DArgs& A, int l, int j) { return (j < wcv::NREST) ? weight_item(A, l, wcv::I1 + j) : weight_item(A, l + 1, j - wcv::NREST); }
__device__ __forceinline__ void wjob_chunk(const DArgs& A, int l, int chunk, LAS unsigned char* lds, int wave, int lane) {
    LAS float* scr = (LAS float*)(lds + wave * 8448);
    const int j0 = chunk * 32 + wave;
    const WItem wa = wjob_item(A, l, j0), wb = wjob_item(A, l, j0 + 8), wc = wjob_item(A, l, j0 + 16), wd = wjob_item(A, l, j0 + 24);
    f32x4 va[8], vb[8], vc[8], vd[8]; float sa[8], sb[8];
    tr_load_data(wa, va, lane); tr_load_scale(wa, sa, lane); tr_load_data(wb, vb, lane); tr_load_data(wc, vc, lane); tr_load_data(wd, vd, lane);
    asm volatile("" ::: "memory");
    tr_load_scale(wb, sb, lane); tr_store(wa, va, sa, scr, lane);
    tr_load_scale(wc, sa, lane); tr_store(wb, vb, sb, scr, lane);
    tr_load_scale(wd, sb, lane); tr_store(wc, vc, sa, scr, lane);
    tr_store(wd, vd, sb, scr, lane);
}
__device__ __forceinline__ void phase_weights(const DArgs& A, int l, LAS unsigned char* lds, int gw, int NGW, int wave, int lane) {
    LAS float* scr = (LAS float*)(lds + wave * 8448);
    for (int it = gw; it < wcv::I1; it += NGW) { const WItem w = weight_item(A, l, it); f32x4 v[8]; float sc[8]; tr_load(w, v, sc, lane); tr_store(w, v, sc, scr, lane); }
}

__device__ __forceinline__ void phase_xprep(const DArgs& A, int gw, int NGW, int lane) {
    const float* x = inp(A, 0); bf16* XB = (bf16*)(wsp(A) + WS_HB); float* SSQ = (float*)(wsp(A) + WS_SSQ);
    for (int row = gw; row < MTOK; row += NGW) {
        const GAS f32x4* xr = (const GAS f32x4*)(x + (size_t)row * DM) + lane;
        f32x4 v[8]; float ss = 0.f;
#pragma unroll
        for (int j = 0; j < 8; ++j) { v[j] = xr[64 * j]; ss += (v[j].x * v[j].x + v[j].y * v[j].y) + (v[j].z * v[j].z + v[j].w * v[j].w); }
        ss = wave_sum(ss);
        GAS unsigned long long* o8 = (GAS unsigned long long*)(XB + (size_t)row * DM) + lane;
#pragma unroll
        for (int j = 0; j < 8; ++j) o8[64 * j] = (unsigned long long)pk2(v[j].x, v[j].y) | ((unsigned long long)pk2(v[j].z, v[j].w) << 32);
        if (lane < 32) SSQ[(size_t)row * 32 + lane] = (lane == 0) ? ss : 0.f;
    }
}
__device__ __forceinline__ void phase_gates(const DArgs& A, int l, LAS unsigned char* lds, int gw, int NGW, int tid, int lane) {
    typedef short bf16x8 __attribute__((ext_vector_type(8)));
    const bf16* XB = (const bf16*)(wsp(A) + WS_HB); const float* SSQ = (const float*)(wsp(A) + WS_SSQ); float* G = (float*)(wsp(A) + WS_G);
    LAS bf16* WgL = (LAS bf16*)lds;
    { const float* w_in = inp(A, 2) + (size_t)l * DM * N_IN; const float* attn_nw = inp(A, 1) + (size_t)l * DM;
      for (int idx = tid; idx < 16 * DM; idx += NTHREADS) { const int k = idx >> 4, g = idx & 15; WgL[g * 2056 + k] = (bf16)f2bf(attn_nw[k] * w_in[(size_t)k * N_IN + SRC_GATE + g]); } }
    __syncthreads();
    const int fr = lane & 15, fq = lane >> 4;
    float bias[4];
#pragma unroll
    for (int i = 0; i < 4; ++i) { const int g = 4 * fq + i; bias[i] = (g < 8) ? inp(A, 5)[l * NHEAD + g] : inp(A, 6)[l * NHEAD + g - 8]; }
    for (int blk = gw; blk < MTOK / 16; blk += NGW) {
        const int row = blk * 16 + fr;
        const GAS bf16x8* xp = (const GAS bf16x8*)(XB + (size_t)row * DM + 8 * fq);
        const LAS bf16x8* wp = (const LAS bf16x8*)(WgL + fr * 2056 + 8 * fq);
        f32x4 acc = {0.f, 0.f, 0.f, 0.f};
#pragma unroll 16
        for (int ks = 0; ks < 64; ++ks) acc = __builtin_amdgcn_mfma_f32_16x16x32_bf16(wp[4 * ks], xp[4 * ks], acc, 0, 0, 0);
        const GAS f32x4* sp = (const GAS f32x4*)(SSQ + (size_t)row * 32); f32x4 t = sp[0];
#pragma unroll
        for (int j = 1; j < 8; ++j) t += sp[j];
        const float r = __builtin_amdgcn_rsqf(((t.x + t.y) + (t.z + t.w)) * (1.0f / DM) + EPS);
        f32x4 o;
#pragma unroll
        for (int i = 0; i < 4; ++i) { const float pre = acc[i] * r + bias[i]; o[i] = (fq < 2) ? pre : (fminf(pre, 0.f) - __logf(1.0f + __expf(-fabsf(pre)))); }
        *(GAS f32x4*)(G + (size_t)row * 16 + 4 * fq) = o;
    }
}

typedef unsigned u32x4 __attribute__((ext_vector_type(4)));
typedef unsigned u32x2 __attribute__((ext_vector_type(2)));
namespace ml {
typedef short bf16x8 __attribute__((ext_vector_type(8)));
typedef float f32x16 __attribute__((ext_vector_type(16)));
constexpr int OFF_Q = 0, OFF_K = 17408, OFF_KT = 34816, OFF_VT = 53248, OFF_ST = 90112, OFF_SC = 99328, OFF_CW = 107520, OFF_HV = 0  ;
constexpr int AS = 0, MLo = 64, INTER = 128, EINV = 192, DS0 = 256, NQ = 384, NV = 448;
__device__ __forceinline__ int swz256(int row, int colB) { return row * 272 + colB; }
__device__ __forceinline__ int swz128(int row, int colB) { return row * 144 + colB; }
__device__ __forceinline__ unsigned pk(float lo, float hi) { return attn::cvtpk(lo, hi); }
template <int CTRL> __device__ __forceinline__ float dppf(float x) { return __builtin_bit_cast(float, __builtin_amdgcn_update_dpp(0, __builtin_bit_cast(int, x), CTRL, 0xf, 0xf, false)); }
__device__ __forceinline__ float scan_add(float x, int lane) {
    const int rl = lane & 15; float t;
    t = dppf<0x111>(x); if (rl >= 1) x += t;
    t = dppf<0x112>(x); if (rl >= 2) x += t;
    t = dppf<0x114>(x); if (rl >= 4) x += t;
    t = dppf<0x118>(x); if (rl >= 8) x += t;
    t = dppf<0x142>(x); if ((lane & 31) >= 16) x += t;
    t = dppf<0x143>(x); if (lane >= 32) x += t;
    return x;
}
__device__ __forceinline__ float scan_max(float x, int lane) {
    const int rl = lane & 15; float t;
    t = dppf<0x111>(x); if (rl >= 1) x = fmaxf(x, t);
    t = dppf<0x112>(x); if (rl >= 2) x = fmaxf(x, t);
    t = dppf<0x114>(x); if (rl >= 4) x = fmaxf(x, t);
    t = dppf<0x118>(x); if (rl >= 8) x = fmaxf(x, t);
    t = dppf<0x142>(x); if ((lane & 31) >= 16) x = fmaxf(x, t);
    t = dppf<0x143>(x); if (lane >= 32) x = fmaxf(x, t);
    return x;
}
}

__device__ __forceinline__ void ml_conv4(const u32x2 (&raw)[7], const LAS float* cwl, int c4, float sc, float (&o)[4][4], LAS unsigned char* dst, int rg) {
    using namespace ml;
    typedef float f32x2v __attribute__((ext_vector_type(2)));
    f32x2v wa[4], wb[4];
#pragma unroll
    for (int j = 0; j < 4; ++j) { const f32x4 w = *(const LAS f32x4*)(cwl + j * 128 + c4); wa[j] = (f32x2v){w.x, w.y}; wb[j] = (f32x2v){w.z, w.w}; }
    const f32x4 bs = *(const LAS f32x4*)(cwl + 4 * 128 + c4);
    f32x2v xa[7], xb[7];
#pragma unroll
    for (int i = 0; i < 7; ++i) { xa[i] = (f32x2v){wlo(raw[i].x), whi(raw[i].x)}; xb[i] = (f32x2v){wlo(raw[i].y), whi(raw[i].y)}; }
#pragma unroll
    for (int i = 0; i < 4; ++i) {
        f32x2v a = {bs.x, bs.y}, b = {bs.z, bs.w};
#pragma unroll
        for (int j = 0; j < 4; ++j) { a = __builtin_elementwise_fma(wa[j], xa[i + j], a); b = __builtin_elementwise_fma(wb[j], xb[i + j], b); }
        o[i][0] = a.x; o[i][1] = a.y; o[i][2] = b.x; o[i][3] = b.y;
#pragma unroll
        for (int e = 0; e < 4; ++e) o[i][e] = o[i][e] * sigm(o[i][e]) * sc;
        u32x2 w; w.x = pk(o[i][0], o[i][1]); w.y = pk(o[i][2], o[i][3]);
        *(LAS u32x2*)(dst + swz256(4 * rg + i, 2 * c4)) = w;
    }
}
__device__ __forceinline__ void phase_mlstm_chunk(const DArgs& A, int l, int bh, LAS unsigned char* L, int tid) {
    using namespace ml;
#define ML_BAR() do { asm volatile("s_waitcnt lgkmcnt(0)" ::: "memory"); __builtin_amdgcn_s_barrier(); asm volatile("" ::: "memory"); } while (0)
    const int lane = tid & 63, wv = __builtin_amdgcn_readfirstlane(tid >> 6), c = lane & 31, hi = lane >> 5;
    const int b = bh >> 3, h = bh & 7;
#define ML_RD(dst, base, off) asm volatile("ds_read_b128 %0, %1 offset:%2" : "=&v"(dst) : "v"(base), "i"(off) : "memory")
#define ML_W(n) do { asm volatile("s_waitcnt lgkmcnt(" #n ")" ::: "memory"); __builtin_amdgcn_sched_barrier(0); } while (0)
    const unsigned lbase = (unsigned)(uintptr_t)L;
    const bf16* P = (const bf16*)(wsp(A) + WS_P); const float* G = (const float*)(wsp(A) + WS_G); bf16* HMD = (bf16*)(wsp(A) + WS_HMD);
    LAS float* SC = (LAS float*)(L + OFF_SC);
    LAS float* CWL = (LAS float*)(L + OFF_CW);
    { unsigned z = 0u; asm volatile("" : "+v"(z));
      if (tid < 128) *(LAS u32x4*)(L + OFF_ST + swz128(tid >> 2, (4 + (tid & 3)) * 16)) = (u32x4){z, z, z, z}; }
    if (tid < 32) SC[DS0 + 64 + tid] = 0.f;
    if (tid < 256) SC[NV + tid] = 0.f;
    { const float* cw = inp(A, 3) + (size_t)l * 4 * DM; const float* cb = inp(A, 4) + (size_t)l * DM;
      for (int idx = tid; idx < 1280; idx += NTHREADS) { const int it = idx / 640, rem = idx - it * 640, j = rem >> 7, cc = rem & 127, chn = (it ? C_MK : C_MQ) + h * 128 + cc;
          CWL[idx] = (j < 4) ? cw[j * DM + chn] : cb[chn]; } }
    f32x16 Cacc[4];
#pragma unroll
    for (int dd = 0; dd < 4; ++dd)
#pragma unroll
        for (int r = 0; r < 16; ++r) Cacc[dd][r] = 0.f;
    float m_prev = 0.f;
    const size_t rowb = (size_t)b * SEQ;
    const int rg = tid >> 5, cg = tid & 31, c4 = 4 * cg;
    u32x2 rq[7], rk[7]; v4u vr[4]; float g_ig, g_lf;
    const int rgv = tid & 15, cgv = tid >> 4;
    const unsigned toq = (unsigned)((4 * rg) * NP + c4) * 2u, tov = (unsigned)((4 * rgv) * NP + 8 * cgv) * 2u, tog = (unsigned)lane * 64u;
    const unsigned tom = (unsigned)(tid >> 3) * (unsigned)(NP * 2) + (unsigned)(tid & 7) * 64u, toh = (unsigned)(tid >> 3) * (unsigned)(4 * DM) + (unsigned)(tid & 7) * 64u;
#define ML_LOAD_RAW(chx, CHK0) do { const size_t r0_ = rowb + (size_t)(chx) * 64; \
        const GAS char* gb_ = (const GAS char*)(G + r0_ * 16 + h); g_ig = *(const GAS float*)(gb_ + tog); g_lf = *(const GAS float*)(gb_ + tog + 32); \
        const GAS char* qb_ = (const GAS char*)(P + r0_ * NP + h * 128) - 3 * NP * 2;     \
        _Pragma("unroll") for (int i = 0; i < 7; ++i) { const bool ok = (CHK0) ? (4 * rg - 3 + i >= 0) : true; \
            rq[i] = ok ? *(const GAS u32x2*)(qb_ + (toq + (unsigned)(i * NP * 2))) : (u32x2){0u, 0u}; rk[i] = ok ? *(const GAS u32x2*)(qb_ + (toq + (unsigned)(i * NP * 2)) + C_MK * 2) : (u32x2){0u, 0u}; } \
        } while (0)
#define ML_LOAD_V(chx) do { const GAS char* vb_ = (const GAS char*)(P + (rowb + (size_t)(chx) * 64) * NP + C_MV + h * 256); \
        _Pragma("unroll") for (int i = 0; i < 4; ++i) vr[i] = *(const GAS v4u*)(vb_ + (tov + (unsigned)(i * NP * 2))); } while (0)
    ML_LOAD_RAW(0, true); ML_LOAD_V(0);
    __syncthreads();
#pragma unroll 1
    for (int ch = 0; ch < SEQ / 64; ++ch) {
        const size_t row0 = rowb + (size_t)ch * 64;
        const float ig = g_ig, lf = g_lf;
        const float bc = scan_add(lf, lane);
        const float a = ig - bc; const float cm = scan_max(a, lane);
        const float Ml = fmaxf(m_prev, cm);
        const float M63 = __builtin_bit_cast(float, __builtin_amdgcn_readlane(__builtin_bit_cast(int, Ml), 63)), b63 = __builtin_bit_cast(float, __builtin_amdgcn_readlane(__builtin_bit_cast(int, bc), 63));
        const float wgt = __expf(a - M63), decay = __expf(m_prev - M63);
        if (wv == 0) { SC[AS + lane] = a; SC[MLo + lane] = Ml; SC[INTER + lane] = __expf(m_prev - Ml); SC[EINV + lane] = __expf(-(bc + Ml)); }
        const int wi_ = __builtin_bit_cast(int, wgt); const float w0 = __builtin_bit_cast(float, __builtin_amdgcn_ds_bpermute(16 * rg, wi_)), w1 = __builtin_bit_cast(float, __builtin_amdgcn_ds_bpermute(16 * rg + 4, wi_)), w2 = __builtin_bit_cast(float, __builtin_amdgcn_ds_bpermute(16 * rg + 8, wi_)), w3 = __builtin_bit_cast(float, __builtin_amdgcn_ds_bpermute(16 * rg + 12, wi_));
        { float o[4][4]; ml_conv4(rq, CWL, c4, 1.0f, o, L + OFF_Q, rg); }
        { float o[4][4]; ml_conv4(rk, CWL + 640, c4, 0.08838834764831845f, o, L + OFF_K, rg);
#pragma unroll
          for (int e = 0; e < 4; ++e) { u32x2 w; w.x = pk(o[0][e] * w0, o[1][e] * w1); w.y = pk(o[2][e] * w2, o[3][e] * w3);
              *(LAS u32x2*)(L + OFF_KT + swz128(c4 + e, 8 * rg)) = w; } }
        {
            const unsigned vw[4][4] = {{vr[0].x, vr[0].y, vr[0].z, vr[0].w}, {vr[1].x, vr[1].y, vr[1].z, vr[1].w}, {vr[2].x, vr[2].y, vr[2].z, vr[2].w}, {vr[3].x, vr[3].y, vr[3].z, vr[3].w}};
#pragma unroll
            for (int e = 0; e < 8; ++e) { const int k = e >> 1; u32x2 w;
                if (e & 1) { w.x = (vw[0][k] >> 16) | (vw[1][k] & 0xffff0000u); w.y = (vw[2][k] >> 16) | (vw[3][k] & 0xffff0000u); }
                else       { w.x = (vw[0][k] & 0xffffu) | (vw[1][k] << 16);     w.y = (vw[2][k] & 0xffffu) | (vw[3][k] << 16); }
                *(LAS u32x2*)(L + OFF_VT + swz128(8 * cgv + e, 8 * rgv)) = w; }
        }
        ML_BAR();
        { const int chn = (ch + 1 < SEQ / 64) ? ch + 1 : 1; ML_LOAD_RAW(chn, false); }
        if (wv < 3) {
            const int lh = (wv == 0) ? 0 : 1, sh = (wv == 2) ? 1 : 0;
            f32x16 acc;
#pragma unroll
            for (int r = 0; r < 16; ++r) acc[r] = 0.f;
            {
                const unsigned skb = lbase + OFF_K + swz256(32 * sh + c, 16 * hi), sqb = lbase + OFF_Q + swz256(32 * lh + c, 16 * hi);
                bf16x8 X0, X1, X2, X3, Y0, Y1, Y2, Y3;
#define S_RD4(S, g) do { ML_RD(S##0, skb, 64 * (g)); ML_RD(S##1, sqb, 64 * (g)); ML_RD(S##2, skb, 64 * (g) + 32); ML_RD(S##3, sqb, 64 * (g) + 32); } while (0)
#define S_MM(S) do { acc = __builtin_amdgcn_mfma_f32_32x32x16_bf16(S##0, S##1, acc, 0, 0, 0); acc = __builtin_amdgcn_mfma_f32_32x32x16_bf16(S##2, S##3, acc, 0, 0, 0); } while (0)
                S_RD4(X, 0);
                S_RD4(Y, 1); ML_W(4); S_MM(X);
                S_RD4(X, 2); ML_W(4); S_MM(Y);
                S_RD4(Y, 3); ML_W(4); S_MM(X);
                ML_W(0); S_MM(Y);
#undef S_RD4
#undef S_MM
            }
            const int tl = 32 * lh + c; const float Mt = SC[MLo + tl]; float rs = 0.f;
#pragma unroll
            for (int g = 0; g < 4; ++g) {
                const int s0 = 32 * sh + 8 * g + 4 * hi; const f32x4 as4 = *(const LAS f32x4*)(SC + AS + s0);
                float vv[4];
#pragma unroll
                for (int e = 0; e < 4; ++e) { const float ev = (s0 + e <= tl) ? __expf(as4[e] - Mt) : 0.f; vv[e] = acc[4 * g + e] * ev; rs += vv[e]; }
                u32x2 w; w.x = pk(vv[0], vv[1]); w.y = pk(vv[2], vv[3]);
                *(LAS u32x2*)(L + OFF_ST + swz128(tl, 2 * s0)) = w;
            }
            { auto t = __builtin_amdgcn_permlane32_swap(__float_as_uint(rs), __float_as_uint(rs), false, false); rs = __uint_as_float(t[0]) + __uint_as_float(t[1]); }
            if (hi == 0) SC[DS0 + sh * 64 + tl] = rs;
        } else if (wv >= 4) {
            const LAS float* nold = SC + NV + (ch & 1) * 128; LAS float* nnew = SC + NV + ((ch + 1) & 1) * 128;
            { const int row = 16 * (wv - 4) + (lane >> 2), qd = lane & 3; float acc = 0.f;
#pragma unroll
              for (int ck = 0; ck < 4; ++ck) { const v4u q8 = *(const LAS v4u*)(L + OFF_Q + swz256(row, (4 * qd + ck) * 16)); const f32x4 n0 = *(const LAS f32x4*)(nold + 32 * qd + 8 * ck), n1 = *(const LAS f32x4*)(nold + 32 * qd + 8 * ck + 4);
                  acc += (wlo(q8.x) * n0.x + whi(q8.x) * n0.y) + (wlo(q8.y) * n0.z + whi(q8.y) * n0.w) + (wlo(q8.z) * n1.x + whi(q8.z) * n1.y) + (wlo(q8.w) * n1.z + whi(q8.w) * n1.w); }
              acc = sum4_f(acc);
              if (qd == 0) SC[NQ + row] = acc; }
            { const int d = 32 * (wv - 4) + (lane >> 1), sh2 = lane & 1; float sm = 0.f;
#pragma unroll
              for (int ck = 0; ck < 4; ++ck) { const v4u k8 = *(const LAS v4u*)(L + OFF_KT + swz128(d, (4 * sh2 + ck) * 16)); sm += ((wlo(k8.x) + whi(k8.x)) + (wlo(k8.y) + whi(k8.y))) + ((wlo(k8.z) + whi(k8.z)) + (wlo(k8.w) + whi(k8.w))); }
              sm += xor1_f(sm);
              if (sh2 == 0) nnew[d] = decay * nold[d] + sm; }
        }
        f32x16 oi[2];
#pragma unroll
        for (int lh = 0; lh < 2; ++lh)
#pragma unroll
            for (int r = 0; r < 16; ++r) oi[lh][r] = 0.f;
        {
            const unsigned qb0 = lbase + OFF_Q + swz256(c, 8 * hi), qb1 = qb0 + 32 * 272;
            bf16x8 X0, X1, X2, X3, Y0, Y1, Y2, Y3;
#define I_RD(dst, base, dd, j2) asm volatile("ds_read2_b64 %0, %1 offset0:%2 offset1:%3" : "=&v"(dst) : "v"(base), "i"(8 * (dd) + 4 * (j2)), "i"(8 * (dd) + 4 * (j2) + 2) : "memory")
#define I_RD4(S, dd) do { I_RD(S##0, qb0, dd, 0); I_RD(S##1, qb1, dd, 0); I_RD(S##2, qb0, dd, 1); I_RD(S##3, qb1, dd, 1); } while (0)
#define I_MM(S, dd) do { \
            const bf16x8 a0_ = attn::pack8((f32x4){Cacc[dd][0], Cacc[dd][1], Cacc[dd][2], Cacc[dd][3]}, (f32x4){Cacc[dd][4], Cacc[dd][5], Cacc[dd][6], Cacc[dd][7]}); \
            const bf16x8 a1_ = attn::pack8((f32x4){Cacc[dd][8], Cacc[dd][9], Cacc[dd][10], Cacc[dd][11]}, (f32x4){Cacc[dd][12], Cacc[dd][13], Cacc[dd][14], Cacc[dd][15]}); \
            oi[0] = __builtin_amdgcn_mfma_f32_32x32x16_bf16(a0_, S##0, oi[0], 0, 0, 0); oi[1] = __builtin_amdgcn_mfma_f32_32x32x16_bf16(a0_, S##1, oi[1], 0, 0, 0); \
            oi[0] = __builtin_amdgcn_mfma_f32_32x32x16_bf16(a1_, S##2, oi[0], 0, 0, 0); oi[1] = __builtin_amdgcn_mfma_f32_32x32x16_bf16(a1_, S##3, oi[1], 0, 0, 0); } while (0)
            I_RD4(X, 0);
            I_RD4(Y, 1); ML_W(4); I_MM(X, 0);
            I_RD4(X, 2); ML_W(4); I_MM(Y, 1);
            I_RD4(Y, 3); ML_W(4); I_MM(X, 2);
            ML_W(0); I_MM(Y, 3);
#undef I_RD
#undef I_RD4
#undef I_MM
        }
        ML_BAR();
        bf16x8 vf[4], sf[4];
        const unsigned stb = lbase + OFF_ST + swz128(c, 16 * hi);
        { const unsigned hvb = lbase + OFF_VT + swz128(32 * wv + c, 16 * hi);
          ML_RD(vf[0], hvb, 0); ML_RD(vf[1], hvb, 32); ML_RD(vf[2], hvb, 64); ML_RD(vf[3], hvb, 96);
          ML_RD(sf[0], stb, 0); ML_RD(sf[1], stb, 32); ML_RD(sf[2], stb, 64); ML_RD(sf[3], stb, 96); }
#pragma unroll
        for (int lh = 0; lh < 2; ++lh) {
            const int tl = 32 * lh + c; const float it = SC[INTER + tl];
            const float den = (SC[DS0 + tl] + SC[DS0 + 64 + tl]) + it * SC[NQ + tl];
            const float inv = __builtin_amdgcn_rcpf(fmaxf(fabsf(den), SC[EINV + tl]));
            f32x16 t = oi[lh] * it;
            ML_W(0);
#pragma unroll
            for (int ks = 0; ks < 4; ++ks) t = __builtin_amdgcn_mfma_f32_32x32x16_bf16(vf[ks], sf[ks], t, 0, 0, 0);
            if (lh == 0) { __builtin_amdgcn_sched_barrier(0); ML_RD(sf[0], stb, 4608); ML_RD(sf[1], stb, 4608 + 32); ML_RD(sf[2], stb, 4608 + 64); ML_RD(sf[3], stb, 4608 + 96); }
#pragma unroll
            for (int g = 0; g < 4; ++g) { u32x2 w;
                w.x = pk(t[4 * g] * inv, t[4 * g + 1] * inv); w.y = pk(t[4 * g + 2] * inv, t[4 * g + 3] * inv);
                *(LAS u32x2*)(L + OFF_HV + tl * 528 + (32 * wv + 8 * g + 4 * hi) * 2) = w; }
        }
        asm volatile("" ::: "memory");
        v4u mo[4];
#pragma unroll
        for (int q = 0; q < 4; ++q) mo[q] = *(const GAS v4u*)((const GAS char*)(P + row0 * NP + C_MO + h * 256) + tom + q * 16);
        ML_BAR();
        {
            const int rl = tid >> 3, sg = tid & 7;
            v4u hq[4]; float ss = 0.f;
#pragma unroll
            for (int q = 0; q < 4; ++q) { hq[q] = *(const LAS v4u*)(L + OFF_HV + rl * 528 + sg * 64 + q * 16);
                const unsigned hw[4] = {hq[q].x, hq[q].y, hq[q].z, hq[q].w};
#pragma unroll
                for (int k = 0; k < 4; ++k) { const float x0 = wlo(hw[k]), x1 = whi(hw[k]); ss += x0 * x0 + x1 * x1; } }
            ss = sum8_f(ss);
            const float rn = __builtin_amdgcn_rsqf(ss * (1.0f / 256.0f) + EPS);
            GAS char* orow = (GAS char*)(HMD + row0 * (2 * DM) + h * 256) + toh;
#pragma unroll
            for (int q = 0; q < 4; ++q) { const unsigned hw[4] = {hq[q].x, hq[q].y, hq[q].z, hq[q].w}; const unsigned mw[4] = {mo[q].x, mo[q].y, mo[q].z, mo[q].w}; unsigned ow[4];
#pragma unroll
                for (int k = 0; k < 4; ++k) ow[k] = pk(wlo(hw[k]) * rn * wlo(mw[k]), whi(hw[k]) * rn * whi(mw[k]));
                *(GAS v4u*)(orow + q * 16) = (v4u){ow[0], ow[1], ow[2], ow[3]}; }
        }
        asm volatile("" ::: "memory");
        { const int chn = (ch + 1 < SEQ / 64) ? ch + 1 : ch; ML_LOAD_V(chn); }
        {
            const unsigned hvb = lbase + OFF_VT + swz128(32 * wv + c, 16 * hi), ktb = lbase + OFF_KT + swz128(c, 16 * hi);
            bf16x8 vf2[4], X0, X1, X2, X3, Y0, Y1, Y2, Y3;
#define U_RD4(S, dd) do { ML_RD(S##0, ktb, (dd) * 4608); ML_RD(S##1, ktb, (dd) * 4608 + 32); ML_RD(S##2, ktb, (dd) * 4608 + 64); ML_RD(S##3, ktb, (dd) * 4608 + 96); } while (0)
#define U_MM(S, dd) do { Cacc[dd] = Cacc[dd] * decay; \
            Cacc[dd] = __builtin_amdgcn_mfma_f32_32x32x16_bf16(S##0, vf2[0], Cacc[dd], 0, 0, 0); Cacc[dd] = __builtin_amdgcn_mfma_f32_32x32x16_bf16(S##1, vf2[1], Cacc[dd], 0, 0, 0); \
            Cacc[dd] = __builtin_amdgcn_mfma_f32_32x32x16_bf16(S##2, vf2[2], Cacc[dd], 0, 0, 0); Cacc[dd] = __builtin_amdgcn_mfma_f32_32x32x16_bf16(S##3, vf2[3], Cacc[dd], 0, 0, 0); } while (0)
            ML_RD(vf2[0], hvb, 0); ML_RD(vf2[1], hvb, 32); ML_RD(vf2[2], hvb, 64); ML_RD(vf2[3], hvb, 96);
            U_RD4(X, 0); U_RD4(Y, 1);
            ML_W(4); U_MM(X, 0);
            U_RD4(X, 2); ML_W(4); U_MM(Y, 1);
            U_RD4(Y, 3); ML_W(4); U_MM(X, 2);
            ML_W(0); U_MM(Y, 3);
#undef U_RD4
#undef U_MM
        }
        m_prev = b63 + M63;
        ML_BAR();
    }
#undef ML_LOAD_RAW
#undef ML_LOAD_V
#undef ML_BAR
#undef ML_RD
#undef ML_W
}

typedef attn::BlockRef<attn::bf16, attn::bf16> ABlock;
constexpr int ATT_ITEMS = NBATCH * NHEAD * 4 * 16;
__device__ __forceinline__ ABlock attn_ref(const DArgs& A, int item) {
    const int vh = item & 127, qb = 15 - (item >> 7), comp = vh & 1, half = (vh >> 1) & 1, h = (vh >> 2) & 7, b = vh >> 5;
    const attn::bf16* P = (const attn::bf16*)(wsp(A) + WS_P);
    attn::bf16* O = (attn::bf16*)(wsp(A) + (comp ? WS_HD2 : WS_HD1));
    ABlock r;
    const size_t row0 = (size_t)b * SEQ;
    r.Q = P + (row0 + (size_t)qb * 256) * NP + C_DQ + h * 256 + comp * 128;
    r.K = P + row0 * NP + C_DK + h * 256 + comp * 128;
    r.V = P + row0 * NP + C_DV + h * 256 + half * 128;
    r.O = O + (row0 + (size_t)qb * 256) * DM + h * 256 + half * 128;
    r.P0 = qb * 256;
    return r;
}
__device__ __forceinline__ void phase_attn(const DArgs& A, char* lds, gu32* ctr, volatile LAS unsigned* qs, int tid) {
    if (tid == 0) { qs[0] = __hip_atomic_fetch_add(ctr, 1u, RLX_AGENT); qs[1] = __hip_atomic_fetch_add(ctr, 1u, RLX_AGENT); }
    __syncthreads();
    int Lc = (int)qs[0], Ln = (int)qs[1];
    if (Lc >= ATT_ITEMS) return;
    ABlock cur = attn_ref(A, Lc);
    attn::Seam<attn::bf16> S;
    attn::causal_swa_prime<attn::bf16, attn::bf16>(cur, SEQ, lds, S);
    for (;;) {
        const bool has_next = Ln < ATT_ITEMS;
        const ABlock nxt = has_next ? attn_ref(A, Ln) : cur;
        attn::causal_swa_block<attn::bf16, attn::bf16>(cur, nxt, SEQ, SEQ, lds, S);
        if (!has_next) break;
        cur = nxt;
        if (tid == 0) qs[0] = __hip_atomic_fetch_add(ctr, 1u, RLX_AGENT);
        __syncthreads();
        Ln = (int)qs[0];
    }
}

namespace at2 {
constexpr int OFF_K = 0  , OFF_V = 32768  , OFF_P = 98304  , OFF_AL = 131072  , OFF_FLG = 132096  , OFF_LI = 132160  , ITEMS = NBATCH * NHEAD * 2 * 32;
}
__device__ __forceinline__ void phase_attn2(const DArgs& A, int l, char* lds, gu32* ctr, volatile LAS unsigned* qs, int tid) {
    typedef attn::bf16 abf; typedef attn::bf16x8 bf16x8; typedef attn::f32x16 f32x16;
    const int wid = __builtin_amdgcn_readfirstlane(tid >> 6), lane = tid & 63, r32 = lane & 31, hi = lane >> 5, pair = wid & 3;
    const bool scorer = wid < 4;
    const int sr = tid >> 4, sc = (tid & 15) * 8, kws = sr * 256 + ((sc * 2) ^ ((sr & 7) << 4))  , vst0 = attn::v_st(sr, sc);
    const unsigned toff = (unsigned)(sr * attn::LDP + sc) * 2u;
    char* K_lds = lds + at2::OFF_K; char* V_lds = lds + at2::OFF_V; char* P_lds = lds + at2::OFF_P;
    float* AL = (float*)(lds + at2::OFF_AL); unsigned* FLG = (unsigned*)(lds + at2::OFF_FLG); float* LI = (float*)(lds + at2::OFF_LI);
    const int vb0 = (int)(uintptr_t)V_lds + attn::v_rd_base(lane);
#define A2_BAR() do { asm volatile("s_waitcnt lgkmcnt(0)" ::: "memory"); __builtin_amdgcn_s_barrier(); asm volatile("" ::: "memory"); } while (0)
    const unsigned xq0 = xb_xcc_id() & 7u;
#define A2_FETCH() do { if (tid == 0) { unsigned r_ = 0xFFFFFFFFu; for (unsigned k_ = qs[1]; k_ < 8u; ++k_) { const unsigned q_ = (xq0 + k_) & 7u; \
            const unsigned i_ = __hip_atomic_fetch_add(ctr + 64 * q_, 1u, RLX_AGENT); if (i_ < 256u) { r_ = q_ * 256u + i_; qs[1] = k_; break; } qs[1] = k_ + 1u; } qs[0] = r_; \
            qs[2] = __hip_atomic_fetch_add(ctr + 32, 1u, RLX_AGENT); } } while (0)
    if (tid == 0) qs[1] = 0u;
    A2_FETCH();
    __syncthreads();
    unsigned item = qs[0], cid = qs[2];
    const unsigned NCH = (unsigned)wjob_chunks(l);
    for (;;) {
        if (cid < NCH) { wjob_chunk(A, l, (int)cid, A.L, wid, lane); __syncthreads(); }
        if (item == 0xFFFFFFFFu) break;
        const int xq = (int)(item >> 8), ii = (int)(item & 255u), qb = 31 - (ii >> 3), hh = ii & 7, bh = xq * 4 + (hh >> 1), comp = hh & 1, h = bh & 7, b = bh >> 3;
        const int P0 = qb * 128, NT = qb * 2 + 2;
        const abf* Pm = (const abf*)(wsp(A) + WS_P); const size_t row0 = (size_t)b * SEQ;
        const abf* Qp = Pm + (row0 + P0) * NP + C_DQ + h * 256 + comp * 128;
        const abf* Kp = Pm + row0 * NP + C_DK + h * 256 + comp * 128;
        const abf* Vp = Pm + row0 * NP + C_DV + h * 256;
        abf* Op = (abf*)(wsp(A) + (comp ? WS_HD2 : WS_HD1)) + (row0 + P0) * DM + h * 256;
        const int s16 = (tid & 255) >> 4;
        const unsigned toff16 = (unsigned)(s16 * attn::LDP + sc) * 2u;
        const int qlo = P0 + pair * 32, qm = qlo + r32 - 4 * hi;
        if (scorer) {
            const int tv_ = tid & 255, vk = ((tv_ >> 5) << 1) | ((tv_ >> 2) & 1), vc = ((tv_ >> 3) & 3) * 32 + (tv_ & 3) * 8;
            const unsigned toffV = (unsigned)(vk * attn::LDP + vc) * 2u;
            const int vst16 = attn::v_st(vk, vc);
            bf16x8 svA[8], svB[8];
#define SV_LOAD(sv, tv_) do { const int tc_ = ((tv_) < NT) ? (tv_) : NT - 1; const abf* vb_ = Vp + (size_t)tc_ * 64 * attn::LDP; \
                _Pragma("unroll") for (int j = 0; j < 4; ++j) { sv[j] = attn::load8<abf>((const abf*)((const char*)(vb_ + 16 * j * attn::LDP) + toffV)); sv[4 + j] = attn::load8<abf>((const abf*)((const char*)(vb_ + 16 * j * attn::LDP + 128) + toffV)); } } while (0)
#define SV_WRITE(sv, tv_) do { char* vd_ = V_lds + ((tv_) & 1) * 32768;     \
                _Pragma("unroll") for (int j = 0; j < 4; ++j) { *(bf16x8*)(vd_ + vst16 + j * 4096) = sv[j]; *(bf16x8*)(vd_ + 16384 + vst16 + j * 4096) = sv[4 + j]; } } while (0)
            SV_LOAD(svA, 0); SV_LOAD(svB, 1);
            bf16x8 qr[8];
#pragma unroll
            for (int d0 = 0; d0 < 8; ++d0) qr[d0] = attn::load8<abf>((const abf*)((const char*)(Qp + (size_t)(pair * 32) * attn::LDP + d0 * 16) + (unsigned)(r32 * attn::LDP + hi * 8) * 2u));
            float m_reg = -1e30f, l_reg = 0.f;
            A2_BAR();
            f32x16 pA0, pA1, pB0, pB1;
            const int kq0 = (int)(uintptr_t)K_lds + r32 * 256, kx = (r32 & 15) << 4;
            const int ka0 = kq0 + ((hi * 16) ^ kx), ka1 = kq0 + ((32 + hi * 16) ^ kx), ka2 = kq0 + ((64 + hi * 16) ^ kx), ka3 = kq0 + ((96 + hi * 16) ^ kx),
                      ka4 = kq0 + ((128 + hi * 16) ^ kx), ka5 = kq0 + ((160 + hi * 16) ^ kx), ka6 = kq0 + ((192 + hi * 16) ^ kx), ka7 = kq0 + ((224 + hi * 16) ^ kx);
            attn::qkt2<0>(pA0, pA1, ka0, ka1, ka2, ka3, ka4, ka5, ka6, ka7, qr);
            A2_BAR();
#define A2_SCORE(t_, C0, C1, N0, N1, KBN, SVS) do { const int tt_ = (t_), pb = tt_ & 1; \
                SV_WRITE(SVS, tt_); \
                SV_LOAD(SVS, tt_ + 2); \
                __builtin_amdgcn_sched_barrier(0); \
                if (tt_ + 1 < NT) attn::qkt2<KBN>(N0, N1, ka0, ka1, ka2, ka3, ka4, ka5, ka6, ka7, qr); \
                { float mn, alpha; bf16x8 pa0, pa1, pa2, pa3; const int kb_ = tt_ * 64; \
                  if (kb_ + 63 > qlo) attn::mask_tile(C0, C1, qm - kb_, (unsigned)SEQ);     \
                  attn::partialSM(C0, C1, m_reg, mn, alpha); \
                  attn::finishSM(C0, C1, alpha, l_reg, pa0, pa1, pa2, pa3); \
                  char* pd = P_lds + pb * 16384 + pair * 4096 + lane * 16; \
                  *(bf16x8*)(pd) = pa0; *(bf16x8*)(pd + 1024) = pa1; *(bf16x8*)(pd + 2048) = pa2; *(bf16x8*)(pd + 3072) = pa3; \
                  if (hi == 0) AL[(pb * 4 + pair) * 32 + r32] = alpha; \
                  const bool any = __any(alpha < 1.f); \
                  if (lane == 0) FLG[pb * 4 + pair] = any ? 1u : 0u; } \
                A2_BAR();                                            \
                } while (0)
            for (int t = 0; t < NT; t += 2) {
                A2_SCORE(t, pA0, pA1, pB0, pB1, 1, svA);
                A2_SCORE(t + 1, pB0, pB1, pA0, pA1, 0, svB);
            }
#undef A2_SCORE
#undef SV_LOAD
#undef SV_WRITE
            A2_BAR();
            if (hi == 0) LI[pair * 32 + r32] = l_reg;
            A2_BAR();
        } else {
            const int kws16 = s16 * 256 + ((sc * 2) ^ ((s16 & 15) << 4));
            bf16x8 sk[4];
#define VK_LOAD(tk_) do { if ((tk_) < NT) { const abf* kb_ = Kp + (size_t)(tk_) * 64 * attn::LDP; \
                _Pragma("unroll") for (int j = 0; j < 4; ++j) sk[j] = attn::load8<abf>((const abf*)((const char*)(kb_ + 16 * j * attn::LDP) + toff16)); } } while (0)
#define VK_WRITE(tk_) do { if ((tk_) < NT) { char* kd_ = K_lds + ((tk_) & 1) * 16384; \
                _Pragma("unroll") for (int j = 0; j < 4; ++j) *(bf16x8*)(kd_ + kws16 + j * 4096) = sk[j]; } } while (0)
            VK_LOAD(0); VK_WRITE(0);
            VK_LOAD(1); VK_WRITE(1);
            VK_LOAD(2);
            f32x16 o[8];
#pragma unroll
            for (int d = 0; d < 8; ++d)
#pragma unroll
                for (int r = 0; r < 16; ++r) o[d][r] = 0.f;
            A2_BAR();
            A2_BAR();
            for (int t = 0; t <= NT; ++t) {
                VK_WRITE(t + 2);
                VK_LOAD(t + 3);
                if (t >= 1) {
                    const int pp = (t - 1) & 1;
                    const unsigned flv = FLG[pp * 4 + pair];
                    const char* ps = P_lds + pp * 16384 + pair * 4096 + lane * 16;
                    const bf16x8 pa0 = *(const bf16x8*)(ps), pa1 = *(const bf16x8*)(ps + 1024), pa2 = *(const bf16x8*)(ps + 2048), pa3 = *(const bf16x8*)(ps + 3072);
                    const int vbb = vb0 + pp * 32768;
                    typedef attn::s16x4 s16x4;
#define A2_TRRD(dst, off) asm volatile("ds_read_b64_tr_b16 %0, %1 offset:%2" : "=&v"(dst) : "v"(vbb), "i"(off) : "memory")
#define A2_RD(S, g) do { constexpr int b_ = ((g) >> 2) * 16384 + ((g) & 3) * 512;     \
                        A2_TRRD(S##l0, b_); A2_TRRD(S##h0, b_ + 2048); A2_TRRD(S##l1, b_ + 4096); A2_TRRD(S##h1, b_ + 6144); A2_TRRD(S##l2, b_ + 8192); A2_TRRD(S##h2, b_ + 10240); A2_TRRD(S##l3, b_ + 12288); A2_TRRD(S##h3, b_ + 14336); } while (0)
#define A2_MM(S, g) do {     \
                        o[g] = __builtin_amdgcn_mfma_f32_32x32x16_bf16((bf16x8){S##l0[0], S##l0[1], S##l0[2], S##l0[3], S##h0[0], S##h0[1], S##h0[2], S##h0[3]}, pa0, o[g], 0, 0, 0); \
                        o[g] = __builtin_amdgcn_mfma_f32_32x32x16_bf16((bf16x8){S##l1[0], S##l1[1], S##l1[2], S##l1[3], S##h1[0], S##h1[1], S##h1[2], S##h1[3]}, pa1, o[g], 0, 0, 0); \
                        o[g] = __builtin_amdgcn_mfma_f32_32x32x16_bf16((bf16x8){S##l2[0], S##l2[1], S##l2[2], S##l2[3], S##h2[0], S##h2[1], S##h2[2], S##h2[3]}, pa2, o[g], 0, 0, 0); \
                        o[g] = __builtin_amdgcn_mfma_f32_32x32x16_bf16((bf16x8){S##l3[0], S##l3[1], S##l3[2], S##l3[3], S##h3[0], S##h3[1], S##h3[2], S##h3[3]}, pa3, o[g], 0, 0, 0); } while (0)
#define A2_W8() do { asm volatile("s_waitcnt lgkmcnt(8)" ::: "memory"); __builtin_amdgcn_sched_barrier(0); } while (0)
#define A2_W0() do { asm volatile("s_waitcnt lgkmcnt(0)" ::: "memory"); __builtin_amdgcn_sched_barrier(0); } while (0)
                    s16x4 Xl0, Xl1, Xl2, Xl3, Xh0, Xh1, Xh2, Xh3, Yl0, Yl1, Yl2, Yl3, Yh0, Yh1, Yh2, Yh3;
                    A2_RD(X, 0);
                    A2_RD(Y, 1);
#define A2_SC(g) do { if (fl != 0u) { const float al = AL[(pp * 4 + pair) * 32 + r32]; o[g] = o[g] * al; } } while (0)
                    const unsigned fl = __builtin_amdgcn_readfirstlane(flv);
                    A2_W8(); A2_SC(0); A2_MM(X, 0);
                    A2_RD(X, 2); A2_W8(); A2_SC(1); A2_MM(Y, 1);
                    A2_RD(Y, 3); A2_W8(); A2_SC(2); A2_MM(X, 2);
                    A2_RD(X, 4); A2_W8(); A2_SC(3); A2_MM(Y, 3);
                    A2_RD(Y, 5); A2_W8(); A2_SC(4); A2_MM(X, 4);
                    A2_RD(X, 6); A2_W8(); A2_SC(5); A2_MM(Y, 5);
                    A2_RD(Y, 7); A2_W8(); A2_SC(6); A2_MM(X, 6);
                    A2_W0(); A2_SC(7); A2_MM(Y, 7);
#undef A2_SC
#undef A2_TRRD
#undef A2_RD
#undef A2_MM
#undef A2_W8
#undef A2_W0
                }
                A2_BAR();
            }
            A2_BAR();
            const float rl = __builtin_amdgcn_rcpf(LI[pair * 32 + r32]);
            char* Ow = (char*)(Op + (size_t)(pair * 32 + r32) * DM) + (hi ? 16 : 0);
#pragma unroll
            for (int g = 0; g < 8; ++g) {
                const f32x16 t = o[g] * rl;
#pragma unroll
                for (int kp = 0; kp < 2; ++kp) {
                    unsigned ax = attn::cvtpk(t[8 * kp], t[8 * kp + 1]), ay = attn::cvtpk(t[8 * kp + 2], t[8 * kp + 3]);
                    unsigned bx = attn::cvtpk(t[8 * kp + 4], t[8 * kp + 5]), by = attn::cvtpk(t[8 * kp + 6], t[8 * kp + 7]);
                    { auto r = __builtin_amdgcn_permlane32_swap(ax, bx, false, false); ax = r[0]; bx = r[1]; }
                    { auto r = __builtin_amdgcn_permlane32_swap(ay, by, false, false); ay = r[0]; by = r[1]; }
                    *(attn::u32x4*)(Ow + g * 64 + kp * 32) = (attn::u32x4){ax, ay, bx, by};
                }
            }
        }
        A2_FETCH();
        __syncthreads();
        item = qs[0]; cid = qs[2];
    }
    for (;;) {
        __syncthreads();
        if (tid == 0) qs[2] = __hip_atomic_fetch_add(ctr + 32, 1u, RLX_AGENT);
        __syncthreads();
        cid = qs[2];
        if (cid >= NCH) break;
        wjob_chunk(A, l, (int)cid, A.L, wid, lane);
    }
#undef A2_FETCH
#undef VK_LOAD
#undef VK_WRITE
#undef A2_BAR
}

__device__ __forceinline__ void phase_combine(const DArgs& A, int l, int gw, int NGW, int lane) {
    const bf16* HD1 = (const bf16*)(wsp(A) + WS_HD1); const bf16* HD2 = (const bf16*)(wsp(A) + WS_HD2);
    bf16* HMD = (bf16*)(wsp(A) + WS_HMD);
    const float* lq1 = inp(A, 8) + l * 128; const float* lk1 = inp(A, 9) + l * 128; const float* lq2 = inp(A, 10) + l * 128; const float* lk2 = inp(A, 11) + l * 128;
    const float s1 = wave_sum(lq1[lane] * lk1[lane] + lq1[lane + 64] * lk1[lane + 64]), s2 = wave_sum(lq2[lane] * lk2[lane] + lq2[lane + 64] * lk2[lane + 64]);
    const float lam = __expf(s1) - __expf(s2) + lam_init_of(l);
    for (int row = gw; row < MTOK; row += NGW) {
        unsigned long long d1[8], d2[8];
#pragma unroll
        for (int j = 0; j < 8; ++j) { const size_t o = (size_t)row * DM + 256 * j + 4 * lane; d1[j] = *(const GAS unsigned long long*)(HD1 + o); d2[j] = *(const GAS unsigned long long*)(HD2 + o); }
#pragma unroll
        for (int j = 0; j < 8; ++j) {
            const unsigned a0 = (unsigned)d1[j], a1 = (unsigned)(d1[j] >> 32), b0 = (unsigned)d2[j], b1 = (unsigned)(d2[j] >> 32);
            const f32x4 d = {wlo(a0) - wlo(b0) * lam, whi(a0) - whi(b0) * lam, wlo(a1) - wlo(b1) * lam, whi(a1) - whi(b1) * lam};
            const float ssd = wave_sum((d.x * d.x + d.y * d.y) + (d.z * d.z + d.w * d.w));
            const float rd = __builtin_amdgcn_rsqf(ssd * (1.0f / 256.0f) + EPS);
            *(GAS unsigned long long*)(HMD + (size_t)row * (2 * DM) + DM + 256 * j + 4 * lane) = (unsigned long long)pk2(d.x * rd, d.y * rd) | ((unsigned long long)pk2(d.z * rd, d.w * rd) << 32);
        }
    }
}

__device__ __forceinline__ void phase_final(const DArgs& A, int gw, int NGW, int lane) {
    const bf16* XB = (const bf16*)(wsp(A) + WS_HB); const float* SSQ = (const float*)(wsp(A) + WS_SSQ); const float* fw = inp(A, 20);
    f32x4 w[8];
#pragma unroll
    for (int j = 0; j < 8; ++j) w[j] = ((const GAS f32x4*)fw)[lane + 64 * j];
    for (int row = gw; row < MTOK; row += NGW) {
        const GAS unsigned long long* xr = (const GAS unsigned long long*)(XB + (size_t)row * DM) + lane;
        unsigned long long v[8];
#pragma unroll
        for (int j = 0; j < 8; ++j) v[j] = xr[64 * j];
        const float sp = (lane < 32) ? SSQ[(size_t)row * 32 + lane] : 0.f;
        const float r = __builtin_amdgcn_rsqf(wave_sum(sp) * (1.0f / DM) + EPS);
        GAS f32x4* o = (GAS f32x4*)(outp(A) + (size_t)row * DM) + lane;
#pragma unroll
        for (int j = 0; j < 8; ++j) { const unsigned a0 = (unsigned)v[j], a1 = (unsigned)(v[j] >> 32); o[64 * j] = (f32x4){wlo(a0), whi(a0), wlo(a1), whi(a1)} * r * w[j]; }
    }
}

__global__ void __launch_bounds__(NTHREADS, 2) hybrid_fwd(Args KA) {
    extern __shared__ __attribute__((aligned(16))) unsigned char lds[];
    LAS unsigned char* L = (LAS unsigned char*)lds;
    DArgs A; A.L = L; A.l_lo = KA.l_lo; A.l_hi = KA.l_hi; A.ph_lo = KA.ph_lo; A.ph_hi = KA.ph_hi; A.do_final = KA.do_final; A.use_bar = KA.use_bar; A.sub = KA.sub; A.qoff = KA.qoff;
    volatile LAS unsigned* MISC = (volatile LAS unsigned*)(L + MISC_OFF);
#define tid (T_)
#define lane (T_ & 63)
#define wave (__builtin_amdgcn_readfirstlane(T_ >> 6))
#define G (GX_)
#define bx (BX_)
#define gw (bx * NWAVES + wave)
#define NGW (G * NWAVES)
#define gtid (bx * NTHREADS + tid)
#define NGT (G * NTHREADS)
    const int T_ = tidx(), BX_ = sopq((int)blockIdx.x), GX_ = sopq((int)gridDim.x);
    gu32* ctl = (gu32*)(KA.ws + WS_CTL);
    for (int u = tid; u < (LDS_BYTES - LDSCTL_OFF) / 4; u += NTHREADS) ((LAS unsigned*)(L + LDSCTL_OFF))[u] = 0u;
    __syncthreads();
    if (tid == 0) {
#pragma unroll
        for (int i = 0; i < 21; ++i) ((LAS unsigned long long*)(L + PTR_OFF))[i] = (unsigned long long)KA.in[i];
    }
    if (tid == 21) ((LAS unsigned long long*)(L + PTR_OFF))[21] = (unsigned long long)KA.out;
    if (tid == 22) ((LAS unsigned long long*)(L + PTR_OFF))[22] = (unsigned long long)KA.ws;
    __syncthreads();
    XcdBarrier bar; bar.bar = (unsigned*)(ctl + CW_BAR); bar.x = 0; bar.st = nullptr;
    if (A.use_bar) bar = xcd_barrier_post((unsigned*)(ctl + CW_BAR), MISC + 8);
#define IN(k) (sopq(A.ph_lo) <= (k) && (k) < sopq(A.ph_hi))
#define SEAM() do { if (A.use_bar) xcd_barrier(bar); else __syncthreads(); } while (0)
#define WSB(off) ((bf16*)(wsp(A) + (off)))
#define WSF(off) ((float*)(wsp(A) + (off)))
#pragma unroll 1
    for (int l = A.l_lo; l < A.l_hi; ++l) {
        if (l == 0 && IN(10)) { const int T_ = tidx(), BX_ = sopq((int)blockIdx.x), GX_ = sopq((int)gridDim.x); phase_xprep(A, gw, NGW, lane); SEAM(); }
        if (IN(0)) { const int T_ = tidx(), BX_ = sopq((int)blockIdx.x), GX_ = sopq((int)gridDim.x);
            if (l == 0) phase_weights(A, l, L, gw, NGW, wave, lane);
            __syncthreads();
            phase_gates(A, l, L, gw, NGW, tid, lane);
            SEAM();
        }
        if (IN(1)) { const int T_ = tidx(), BX_ = sopq((int)blockIdx.x), GX_ = sopq((int)gridDim.x);
            pg8::Gemm g{WSB(WS_HB), WSB(WS_W1), MTOK, NP, DM, DM}; pg8::StaticOrder S; S.init(MTOK, NP, G, bx);
            pg8::Unit u0; u0.pm = 0; u0.pn = 0; u0.kh = 0; (void)S.next(0, u0);
            if (tid < 256) { const GAS f32x4* sp = (const GAS f32x4*)(WSF(WS_SSQ) + (size_t)(u0.pm * 256 + tid) * 32); f32x4 t = sp[0];
#pragma unroll
                for (int j = 1; j < 8; ++j) t += sp[j];
                ((LAS float*)(L + RT_OFF))[tid] = __builtin_amdgcn_rsqf(((t.x + t.y) + (t.z + t.w)) * (1.0f / DM) + EPS); }
            __syncthreads();
            pg8::EpiStoreBf16R E{WSB(WS_P), NP, WSF(WS_SSQ), (LAS float*)(L + RT_OFF), u0.pm, C_MO / 256, (C_MO + NHEAD * 256) / 256};
            pg8::gemm_phase<pg8::EpiStoreBf16R, pg8::StaticOrder, true, true>(L, g, S, E);
            SEAM();
        }
        if (IN(3)) { const int T_ = tidx(), BX_ = sopq((int)blockIdx.x), GX_ = sopq((int)gridDim.x);
            if (bx < MLSTM_WGS && (sopq(A.sub) & 1)) phase_mlstm_chunk(A, l, bx, L, tid);
            __syncthreads();
            if (sopq(A.sub) & 2) phase_attn2(A, l, (char*)lds, ctl + CW_Q + 512 * (sopq(A.qoff) + l), MISC + 16, tid);
            SEAM();
        }
        if (IN(4)) { const int T_ = tidx(), BX_ = sopq((int)blockIdx.x), GX_ = sopq((int)gridDim.x); phase_combine(A, l, gw, NGW, lane); SEAM(); }
        if (IN(5)) { const int T_ = tidx(), BX_ = sopq((int)blockIdx.x), GX_ = sopq((int)gridDim.x);
            pg8::Gemm g{WSB(WS_HMD), WSB(WS_W2), MTOK, DM, DM, 2 * DM}; pg8::HalfKOrder S; S.init(MTOK, DM, G, bx);
            pg8::EpiGated E{WSB(WS_P), NP, C_GM, C_GD, WSB(WS_Y), DM};
            pg8::gemm_phase<pg8::EpiGated, pg8::HalfKOrder, true, true>(L, g, S, E);
            SEAM();
        }
        if (IN(6)) { const int T_ = tidx(), BX_ = sopq((int)blockIdx.x), GX_ = sopq((int)gridDim.x);
            pg8::Gemm g{WSB(WS_Y), WSB(WS_W3), MTOK, DM, DM, DM}; pg8::StaticOrder S; S.init(MTOK, DM, G, bx);
            pg8::EpiResidB E{WSB(WS_HB), WSF(WS_SSQ), nullptr, DM};
            pg8::gemm_phase<pg8::EpiResidB, pg8::StaticOrder, true, true>(L, g, S, E);
            SEAM();
        }
        if (IN(8)) { const int T_ = tidx(), BX_ = sopq((int)blockIdx.x), GX_ = sopq((int)gridDim.x);
            pg8::Gemm g{WSB(WS_HB), WSB(WS_W4), MTOK, 2 * DFF, DM, DM}; pg8::StaticOrder S; S.init(MTOK, 2 * DFF, G, bx);
            pg8::Unit u0; u0.pm = 0; u0.pn = 0; u0.kh = 0; (void)S.next(0, u0);
            if (tid < 256) { const GAS f32x4* sp = (const GAS f32x4*)(WSF(WS_SSQ) + (size_t)(u0.pm * 256 + tid) * 32); f32x4 t = sp[0];
#pragma unroll
                for (int j = 1; j < 8; ++j) t += sp[j];
                ((LAS float*)(L + RT_OFF))[tid] = __builtin_amdgcn_rsqf(((t.x + t.y) + (t.z + t.w)) * (1.0f / DM) + EPS); }
            __syncthreads();
            pg8::EpiSwigluR E{WSB(WS_P), DFF, WSF(WS_SSQ), (LAS float*)(L + RT_OFF), u0.pm};
            pg8::gemm_phase<pg8::EpiSwigluR, pg8::StaticOrder, true, true>(L, g, S, E);
            SEAM();
        }
        if (IN(9)) { const int T_ = tidx(), BX_ = sopq((int)blockIdx.x), GX_ = sopq((int)gridDim.x);
            pg8::Gemm g{WSB(WS_P), WSB(WS_W5), MTOK, DM, DFF, DFF}; pg8::StaticOrder S; S.init(MTOK, DM, G, bx);
            pg8::EpiResidB E{WSB(WS_HB), WSF(WS_SSQ), nullptr, DM};
            pg8::gemm_phase<pg8::EpiResidB, pg8::StaticOrder, true, true>(L, g, S, E);
            SEAM();
        }
    }
    if (A.do_final) { const int T_ = tidx(), BX_ = sopq((int)blockIdx.x), GX_ = sopq((int)gridDim.x); phase_final(A, gw, NGW, lane); }
#undef IN
#undef SEAM
#undef WSB
#undef WSF
#undef tid
#undef lane
#undef wave
#undef G
#undef bx
#undef gw
#undef NGW
#undef gtid
#undef NGT
}

#ifndef MK_ONE_LAUNCH
#define MK_ONE_LAUNCH 1
#endif
extern "C" void kernel_launch(void* const* d_in, const int* in_sizes, int n_in, void* d_out, int out_size, void* d_ws, size_t ws_size, hipStream_t stream) {
    static int grid = 0;
    if (grid == 0) {
        if (n_in != 21 || in_sizes[0] != MTOK * DM || out_size != MTOK * DM || ws_size < WS_END) {
            fprintf(stderr, "kernel_launch: shape mismatch (n_in %d, in0 %d, out %d, ws %zu); nothing launched\n", n_in, n_in > 0 ? in_sizes[0] : -1, out_size, ws_size); grid = -1; return; }
        int dev = 0, cus = 0, per_cu = 0;
        if (hipGetDevice(&dev) != hipSuccess || hipDeviceGetAttribute(&cus, hipDeviceAttributeMultiprocessorCount, dev) != hipSuccess) { grid = -1; return; }
        if (hipFuncSetAttribute((const void*)hybrid_fwd, hipFuncAttributeMaxDynamicSharedMemorySize, LDS_BYTES) != hipSuccess) { fprintf(stderr, "kernel_launch: hipFuncSetAttribute failed\n"); grid = -1; return; }
        if (hipOccupancyMaxActiveBlocksPerMultiprocessor(&per_cu, (const void*)hybrid_fwd, NTHREADS, LDS_BYTES) != hipSuccess || per_cu < 1)
            fprintf(stderr, "kernel_launch: note: occupancy query reports %d workgroups per CU\n", per_cu);
        (void)hipGetLastError();
        grid = cus;
    }
    if (grid < 0) return;
    if (hipMemsetAsync((char*)d_ws + WS_CTL, 0, CTL_ZERO_BYTES, stream) != hipSuccess) { fprintf(stderr, "kernel_launch: memset failed\n"); return; }
    Args a{};
    for (int i = 0; i < 21; ++i) a.in[i] = (const float*)d_in[i];
    a.out = (float*)d_out; a.ws = (unsigned char*)d_ws; a.sub = 3; a.qoff = 0;
#if MK_ONE_LAUNCH
    a.l_lo = 0; a.l_hi = DEPTH; a.ph_lo = 0; a.ph_hi = 11; a.do_final = 1; a.use_bar = 1;
    hipLaunchKernelGGL(hybrid_fwd, dim3(grid), dim3(NTHREADS), LDS_BYTES, stream, a);
#else
#ifndef PROBE_DUP
#define PROBE_DUP 0x0
#endif
#ifndef PROBE_SUB
#define PROBE_SUB 1
#endif
    for (int l = 0; l < DEPTH; ++l)
        for (int pi = 0; pi < 11; ++pi) {
            const int ph = (pi == 0) ? 10 : pi - 1;
            if (ph == 2 || ph == 7 || (ph == 10 && l != 0)) continue;
            a.l_lo = l; a.l_hi = l + 1; a.ph_lo = ph; a.ph_hi = ph + 1; a.do_final = 0; a.use_bar = 0;
            for (int rep = 0; rep < (((PROBE_DUP >> ph) & 1) ? 2 : 1); ++rep) {
                a.sub = (rep == 1 && ph == 3) ? PROBE_SUB : 3; a.qoff = (rep == 1) ? 4 : 0;
                hipLaunchKernelGGL(hybrid_fwd, dim3(grid), dim3(NTHREADS), LDS_BYTES, stream, a); }
        }
    a.l_lo = 0; a.l_hi = 0; a.ph_lo = 0; a.ph_hi = 0; a.do_final = 1; a.use_bar = 0;
    hipLaunchKernelGGL(hybrid_fwd, dim3(grid), dim3(NTHREADS), LDS_BYTES, stream, a);
#endif
    const hipError_t le = hipPeekAtLastError();
    if (le != hipSuccess) fprintf(stderr, "kernel_launch: launch failed: %s\n", hipGetErrorName(le));
}
```
